# Optimizing an MI355X kernel written in HIP

```python
import math
import jax
import jax.numpy as jnp
from jax import lax
import numpy as np

D_MODEL = 1024
BATCH = 8
SEQ = 2048
DEPTH = 2

GRID_W = 64
CTX_LEN = 256
HEAD_DIM = 64
BLOCK = 128
WINDOW = 128
ROPE_BASE = 10000.0
AX_FREQS = HEAD_DIM // 4
NEG_INF = -1e30
A_HEADS = D_MODEL // 128
A_KV_HEADS = 2
A_WIDTH = A_HEADS * HEAD_DIM
A_KV_WIDTH = A_KV_HEADS * HEAD_DIM
B_WIDTH = D_MODEL // 2
S5_GROUP = 16
S5_GROUPS = B_WIDTH // S5_GROUP
S5_STATE = 64
C_HEADS = D_MODEL // 256
C_WIDTH = C_HEADS * 2 * HEAD_DIM
N_BRANCH = 3
IN_WIDTHS = (A_WIDTH, A_KV_WIDTH, A_KV_WIDTH, A_WIDTH,
             B_WIDTH, B_WIDTH,
             C_WIDTH, C_WIDTH, C_WIDTH, C_WIDTH,
             N_BRANCH * D_MODEL)
IN_WIDTH = sum(IN_WIDTHS)

kernel_name = "hybrid_swa_s5_diffattn_prefix_block"


def rms_norm(x, w, eps=1e-6):
    xf = x.astype(jnp.float32)
    xf = xf * lax.rsqrt(jnp.mean(xf * xf, axis=-1, keepdims=True) + eps)
    return (xf * w.astype(jnp.float32)).astype(x.dtype)


def modulated_projection(h, shift, scale, norm_w, w_in):
    hn = rms_norm(h, norm_w) * (1.0 + scale) + shift
    z = hn @ w_in
    parts = []
    start = 0
    for width in IN_WIDTHS:
        parts.append(z[..., start:start + width])
        start += width
    return parts


def heads(t, n):
    return t.reshape(t.shape[:-1] + (n, -1))


def axial_rope_tables(n_tokens):
    rows = n_tokens // GRID_W
    pos_r = jnp.repeat(jnp.arange(rows, dtype=jnp.float32), GRID_W)
    pos_c = jnp.tile(jnp.arange(GRID_W, dtype=jnp.float32), rows)
    inv = ROPE_BASE ** (-jnp.arange(AX_FREQS, dtype=jnp.float32) / AX_FREQS)
    ang_r = pos_r[:, None] * inv[None]
    ang_c = pos_c[:, None] * inv[None]
    ang = jnp.concatenate([ang_r, ang_r, ang_c, ang_c], axis=-1)
    return jnp.cos(ang), jnp.sin(ang)


def apply_rope(t, cos, sin):
    shape = (t.shape[1],) + (1,) * (t.ndim - 3) + (HEAD_DIM,)
    cs = cos.reshape(shape)
    sn = sin.reshape(shape)
    tf = t.astype(jnp.float32)
    th = tf.reshape(tf.shape[:-1] + (2, 2, AX_FREQS))
    rot = jnp.stack([-th[..., 1, :], th[..., 0, :]], axis=-2).reshape(tf.shape)
    return (tf * cs + rot * sn).astype(t.dtype)


def swa_context(q, k, v, sink):
    b, n, h, dh = q.shape
    hk = k.shape[2]
    g = h // hk
    qg = q.reshape(b, n, hk, g, dh)
    s = jnp.einsum('bqkgd,bckd->bkgqc', qg, k).astype(jnp.float32) * (dh ** -0.5)
    s_sink = jnp.broadcast_to(sink.astype(jnp.float32).reshape(1, hk, g, 1, 1), s.shape[:-1] + (1,))
    p = jax.nn.softmax(jnp.concatenate([s, s_sink], axis=-1), axis=-1)[..., :-1]
    o = jnp.einsum('bkgqc,bckd->bqkgd', p.astype(v.dtype), v)
    return o.reshape(b, n, h * dh)


def swa_latent(q, k, v, k_ctx, v_ctx, sink):
    b, n, h, dh = q.shape
    hk = k.shape[2]
    g = h // hk
    nb = n // BLOCK
    scale = dh ** -0.5
    qb = q.reshape(b, nb, BLOCK, hk, g, dh)

    def band(t):
        tp = jnp.pad(t, ((0, 0), (BLOCK, BLOCK), (0, 0), (0, 0))).reshape(b, nb + 2, BLOCK, hk, dh)
        return jnp.concatenate([tp[:, :-2], tp[:, 1:-1], tp[:, 2:]], axis=2)

    kb, vb = band(k), band(v)
    s_loc = jnp.einsum('bnqkgd,bnmkd->bnkgqm', qb, kb).astype(jnp.float32) * scale
    s_ctx = jnp.einsum('bnqkgd,bckd->bnkgqc', qb, k_ctx).astype(jnp.float32) * scale
    r = jnp.arange(BLOCK)[:, None]
    m = jnp.arange(3 * BLOCK)[None, :]
    rel = m - r
    in_band = (rel >= BLOCK - WINDOW) & (rel <= BLOCK + WINDOW)
    key_pos = (jnp.arange(nb) * BLOCK - BLOCK)[:, None, None] + m[None]
    mask = in_band[None] & (key_pos >= 0) & (key_pos < n)
    s_loc = jnp.where(mask[None, :, None, None], s_loc, NEG_INF)
    s_sink = jnp.broadcast_to(sink.astype(jnp.float32).reshape(1, 1, hk, g, 1, 1), s_loc.shape[:-1] + (1,))
    p = jax.nn.softmax(jnp.concatenate([s_loc, s_ctx, s_sink], axis=-1), axis=-1)
    n_ctx = k_ctx.shape[1]
    w_loc = p[..., :3 * BLOCK].astype(v.dtype)
    w_ctx = p[..., 3 * BLOCK:3 * BLOCK + n_ctx].astype(v.dtype)
    o = (jnp.einsum('bnkgqm,bnmkd->bnqkgd', w_loc, vb)
         + jnp.einsum('bnkgqc,bckd->bnqkgd', w_ctx, v_ctx))
    return o.reshape(b, n, h * dh)


def diff_attention(q, k, v, lam, subln_w, lam_init):
    b, lq, h, _, dh = q.shape
    nb = lq // BLOCK
    scale = dh ** -0.5
    qb = jnp.moveaxis(q.reshape(b, nb, BLOCK, h, 2, dh), 1, 0)

    def one_block(qblk):
        s = jnp.einsum('bqhjd,bkhjd->bhjqk', qblk, k).astype(jnp.float32) * scale
        p = jax.nn.softmax(s, axis=-1)
        a = p[:, :, 0] - lam * p[:, :, 1]
        return jnp.einsum('bhqk,bkhe->bqhe', a.astype(v.dtype), v)

    o = lax.map(one_block, qb)
    o = jnp.moveaxis(o, 0, 1).reshape(b, lq, h, 2 * dh)
    o = rms_norm(o, subln_w) * (1.0 - lam_init)
    return o.reshape(b, lq, h * 2 * dh)


def s5_discretize(a_re, a_im, log_dt, b_re, b_im):
    a_re = a_re.astype(jnp.float32)
    a_im = a_im.astype(jnp.float32)
    dt = jnp.exp(log_dt.astype(jnp.float32))[:, None]
    mag = jnp.exp(a_re * dt)
    abar_re = mag * jnp.cos(a_im * dt)
    abar_im = mag * jnp.sin(a_im * dt)
    den = a_re * a_re + a_im * a_im
    nr = abar_re - 1.0
    ni = abar_im
    f_re = ((nr * a_re + ni * a_im) / den)[..., None]
    f_im = ((ni * a_re - nr * a_im) / den)[..., None]
    b_re = b_re.astype(jnp.float32)
    b_im = b_im.astype(jnp.float32)
    bbar_re = f_re * b_re - f_im * b_im
    bbar_im = f_re * b_im + f_im * b_re
    return abar_re, abar_im, bbar_re, bbar_im


def s5_states(u, abar_re, abar_im, bbar_re, bbar_im, h0, reverse):
    bu_re = jnp.einsum('blgh,gph->blgp', u, bbar_re)
    bu_im = jnp.einsum('blgh,gph->blgp', u, bbar_im)
    if h0 is not None:
        h0_re, h0_im = h0
        start = -1 if reverse else 0
        bu_re = bu_re.at[:, start].add(abar_re * h0_re - abar_im * h0_im)
        bu_im = bu_im.at[:, start].add(abar_re * h0_im + abar_im * h0_re)
    n = u.shape[1]
    a_re = jnp.broadcast_to(abar_re, (1, n) + abar_re.shape)
    a_im = jnp.broadcast_to(abar_im, (1, n) + abar_im.shape)

    def combine(e1, e2):
        a1r, a1i, b1r, b1i = e1
        a2r, a2i, b2r, b2i = e2
        return (a2r * a1r - a2i * a1i,
                a2r * a1i + a2i * a1r,
                a2r * b1r - a2i * b1i + b2r,
                a2r * b1i + a2i * b1r + b2i)

    _, _, h_re, h_im = lax.associative_scan(combine, (a_re, a_im, bu_re, bu_im), reverse=reverse, axis=1)
    return h_re, h_im


def s5_final(h, reverse):
    idx = 0 if reverse else -1
    return (h[0][:, idx], h[1][:, idx])


def s5_readout(h, c_re, c_im):
    return (jnp.einsum('blgp,ghp->blgh', h[0], c_re.astype(jnp.float32))
            - jnp.einsum('blgp,ghp->blgh', h[1], c_im.astype(jnp.float32)))


def s5_output(u, h_f, h_b, c_f, c_b, d_skip, w_glu, b_glu, dtype):
    b, n = u.shape[:2]
    y = (s5_readout(h_f, c_f[0], c_f[1]) + s5_readout(h_b, c_b[0], c_b[1])
         + d_skip.astype(jnp.float32).reshape(S5_GROUPS, S5_GROUP) * u)
    y = jax.nn.gelu(y.reshape(b, n, B_WIDTH).astype(dtype))
    return y * jax.nn.sigmoid(y @ w_glu + b_glu)


def merge_branches(o_a, o_b, o_c, g_a, g_b, g_c, z_merge, w_o_a, w_o_b, w_o_c, w_out):
    gm = jax.nn.sigmoid(z_merge.astype(jnp.float32)).astype(o_a.dtype)
    m_a = gm[..., :D_MODEL]
    m_b = gm[..., D_MODEL:2 * D_MODEL]
    m_c = gm[..., 2 * D_MODEL:]
    y = (m_a * ((o_a * jax.nn.silu(g_a)) @ w_o_a)
         + m_b * ((o_b * jax.nn.silu(g_b)) @ w_o_b)
         + m_c * ((o_c * jax.nn.silu(g_c)) @ w_o_c))
    return y @ w_out


def setup_inputs(seed: int = 0) -> dict:
    key = jax.random.key(seed)
    ks = jax.random.split(key, 32)
    f32 = jnp.float32
    nrm = lambda k, s: jax.random.normal(k, s, dtype=f32)
    G, P, H = S5_GROUPS, S5_STATE, S5_GROUP
    a_im_init = jnp.broadcast_to(jnp.pi * jnp.arange(P, dtype=f32), (DEPTH, 2, G, P))
    return {
        "x": nrm(ks[0], (BATCH, SEQ, D_MODEL)),
        "c": nrm(ks[1], (BATCH, D_MODEL)),
        "ctx": nrm(ks[2], (BATCH, CTX_LEN, D_MODEL)),
        "c_ctx": nrm(ks[3], (D_MODEL,)),
        "w_mod": nrm(ks[4], (DEPTH, D_MODEL, 3 * D_MODEL)) * (0.5 * D_MODEL ** -0.5),
        "b_mod": 0.02 * nrm(ks[5], (DEPTH, 3 * D_MODEL)),
        "norm_pre": 1.0 + 0.02 * nrm(ks[6], (DEPTH, D_MODEL)),
        "norm_post": 1.0 + 0.02 * nrm(ks[7], (DEPTH, D_MODEL)),
        "w_in": nrm(ks[8], (DEPTH, D_MODEL, IN_WIDTH)) * D_MODEL ** -0.5,
        "swa_sink": 0.5 * nrm(ks[9], (DEPTH, A_HEADS)),
        "s5_a_re": -0.5 + 0.01 * nrm(ks[10], (DEPTH, 2, G, P)),
        "s5_a_im": a_im_init + 0.01 * nrm(ks[11], (DEPTH, 2, G, P)),
        "s5_log_dt": jax.random.uniform(ks[12], (DEPTH, 2, G), dtype=f32,
                                        minval=math.log(1e-3), maxval=math.log(1e-1)),
        "s5_b_re": nrm(ks[13], (DEPTH, 2, G, P, H)) * (2 * H) ** -0.5,
        "s5_b_im": nrm(ks[14], (DEPTH, 2, G, P, H)) * (2 * H) ** -0.5,
        "s5_c_re": nrm(ks[15], (DEPTH, 2, G, H, P)) * P ** -0.5,
        "s5_c_im": nrm(ks[16], (DEPTH, 2, G, H, P)) * P ** -0.5,
        "s5_d": nrm(ks[17], (DEPTH, B_WIDTH)),
        "s5_w_glu": nrm(ks[18], (DEPTH, B_WIDTH, B_WIDTH)) * B_WIDTH ** -0.5,
        "s5_b_glu": 0.02 * nrm(ks[19], (DEPTH, B_WIDTH)),
        "diff_lq1": 0.1 * nrm(ks[20], (DEPTH, HEAD_DIM)),
        "diff_lk1": 0.1 * nrm(ks[21], (DEPTH, HEAD_DIM)),
        "diff_lq2": 0.1 * nrm(ks[22], (DEPTH, HEAD_DIM)),
        "diff_lk2": 0.1 * nrm(ks[23], (DEPTH, HEAD_DIM)),
        "diff_subln": 1.0 + 0.02 * nrm(ks[24], (DEPTH, 2 * HEAD_DIM)),
        "w_o_a": nrm(ks[25], (DEPTH, A_WIDTH, D_MODEL)) * A_WIDTH ** -0.5,
        "w_o_b": nrm(ks[26], (DEPTH, B_WIDTH, D_MODEL)) * B_WIDTH ** -0.5,
        "w_o_c": nrm(ks[27], (DEPTH, C_WIDTH, D_MODEL)) * C_WIDTH ** -0.5,
        "w_out": nrm(ks[28], (DEPTH, D_MODEL, D_MODEL)) * D_MODEL ** -0.5,
    }


def reference(x, c, ctx, c_ctx, w_mod, b_mod, norm_pre, norm_post, w_in, swa_sink,
              s5_a_re, s5_a_im, s5_log_dt, s5_b_re, s5_b_im, s5_c_re, s5_c_im,
              s5_d, s5_w_glu, s5_b_glu, diff_lq1, diff_lk1, diff_lq2, diff_lk2, diff_subln,
              w_o_a, w_o_b, w_o_c, w_out):
    bsz, n_lat, _ = x.shape
    n_ctx = ctx.shape[1]
    cos, sin = axial_rope_tables(n_lat)
    h_lat, h_ctx = x, ctx
    for l in range(DEPTH):
        lam_init = 0.8 - 0.6 * math.exp(-0.3 * l)
        mod_lat = jax.nn.silu(c) @ w_mod[l] + b_mod[l]
        mod_ctx = jax.nn.silu(c_ctx) @ w_mod[l] + b_mod[l]
        sh_l = mod_lat[:, None, :D_MODEL]
        sc_l = mod_lat[:, None, D_MODEL:2 * D_MODEL]
        gt_l = mod_lat[:, None, 2 * D_MODEL:]
        sh_c = mod_ctx[:D_MODEL]
        sc_c = mod_ctx[D_MODEL:2 * D_MODEL]
        gt_c = mod_ctx[2 * D_MODEL:]
        (aq_l, ak_l, av_l, ag_l, bu_l, bg_l, cq_l, ck_l, cv_l, cg_l, mg_l) = modulated_projection(
            h_lat, sh_l, sc_l, norm_pre[l], w_in[l])
        (aq_c, ak_c, av_c, ag_c, bu_c, bg_c, cq_c, ck_c, cv_c, cg_c, mg_c) = modulated_projection(
            h_ctx, sh_c, sc_c, norm_pre[l], w_in[l])

        a_kc = heads(ak_c, A_KV_HEADS)
        a_vc = heads(av_c, A_KV_HEADS)
        a_q = apply_rope(heads(aq_l, A_HEADS), cos, sin)
        a_k = apply_rope(heads(ak_l, A_KV_HEADS), cos, sin)
        o_a_l = swa_latent(a_q, a_k, heads(av_l, A_KV_HEADS), a_kc, a_vc, swa_sink[l])

        disc = [s5_discretize(s5_a_re[l, d], s5_a_im[l, d], s5_log_dt[l, d], s5_b_re[l, d], s5_b_im[l, d])
                for d in range(2)]
        u_c = bu_c.astype(jnp.float32).reshape(bsz, n_ctx, S5_GROUPS, S5_GROUP)
        u_l = bu_l.astype(jnp.float32).reshape(bsz, n_lat, S5_GROUPS, S5_GROUP)
        hc_f = s5_states(u_c, *disc[0], None, False)
        hc_b = s5_states(u_c, *disc[1], None, True)
        hl_f = s5_states(u_l, *disc[0], s5_final(hc_f, False), False)
        hl_b = s5_states(u_l, *disc[1], s5_final(hc_b, True), True)
        c_f = (s5_c_re[l, 0], s5_c_im[l, 0])
        c_b = (s5_c_re[l, 1], s5_c_im[l, 1])
        o_b_l = s5_output(u_l, hl_f, hl_b, c_f, c_b, s5_d[l], s5_w_glu[l], s5_b_glu[l], x.dtype)

        lam = (jnp.exp(jnp.sum(diff_lq1[l].astype(jnp.float32) * diff_lk1[l].astype(jnp.float32)))
               - jnp.exp(jnp.sum(diff_lq2[l].astype(jnp.float32) * diff_lk2[l].astype(jnp.float32)))
               + lam_init)
        c_kc = ck_c.reshape(bsz, n_ctx, C_HEADS, 2, HEAD_DIM)
        c_vc = cv_c.reshape(bsz, n_ctx, C_HEADS, 2 * HEAD_DIM)
        c_q = apply_rope(cq_l.reshape(bsz, n_lat, C_HEADS, 2, HEAD_DIM), cos, sin)
        c_k = apply_rope(ck_l.reshape(bsz, n_lat, C_HEADS, 2, HEAD_DIM), cos, sin)
        c_v = cv_l.reshape(bsz, n_lat, C_HEADS, 2 * HEAD_DIM)
        o_c_l = diff_attention(c_q, jnp.concatenate([c_kc, c_k], axis=1),
                               jnp.concatenate([c_vc, c_v], axis=1), lam, diff_subln[l], lam_init)

        y_l = merge_branches(o_a_l, o_b_l, o_c_l, ag_l, bg_l, cg_l, mg_l,
                             w_o_a[l], w_o_b[l], w_o_c[l], w_out[l])
        h_lat_new = h_lat + gt_l * rms_norm(y_l, norm_post[l])

        if l < DEPTH - 1:
            o_a_c = swa_context(heads(aq_c, A_HEADS), a_kc, a_vc, swa_sink[l])
            o_b_c = s5_output(u_c, hc_f, hc_b, c_f, c_b, s5_d[l], s5_w_glu[l], s5_b_glu[l], x.dtype)
            o_c_c = diff_attention(cq_c.reshape(bsz, n_ctx, C_HEADS, 2, HEAD_DIM), c_kc, c_vc,
                                   lam, diff_subln[l], lam_init)
            y_c = merge_branches(o_a_c, o_b_c, o_c_c, ag_c, bg_c, cg_c, mg_c,
                                 w_o_a[l], w_o_b[l], w_o_c[l], w_out[l])
            h_ctx = h_ctx + gt_c * rms_norm(y_c, norm_post[l])
        h_lat = h_lat_new
    return h_lat
```

```cpp
#include <hip/hip_runtime.h>
#include <hip/hip_cooperative_groups.h>
#include <cstdio>
#include <cstdint>
namespace cg = cooperative_groups;
#ifndef MK_PER_PHASE
#define MK_PER_PHASE 0
#endif
namespace pg8 {
#define PG8_LAS __attribute__((address_space(3)))
typedef unsigned short bf16_t;
typedef short bf16x8 __attribute__((ext_vector_type(8)));
typedef float f32x4 __attribute__((ext_vector_type(4)));
typedef unsigned u32x4 __attribute__((ext_vector_type(4)));
constexpr int BM = 256, BK = 64, HALF = 128, HTB = HALF * BK * 2  , STAGE_BYTES = 8 * HTB, NXCD = 8, WGM = 8;

__host__ __device__ __forceinline__ int lds_byte(int r, int c) { const int st = (r >> 4) * 2 + (c >> 5), rr = r & 15, cc = c & 31, ob = rr * 64 + cc * 2; return st * 1024 + (ob ^ (((ob >> 9) & 1) << 5)); }
__host__ __device__ __forceinline__ void stage_rc(int b, int& R, int& C) { const int st = b / 1024, sb = b % 1024, swz = sb ^ (((sb >> 9) & 1) << 5); R = (st >> 1) * 16 + swz / 64; C = (st & 1) * 32 + (swz % 64) / 2; }
__host__ __device__ __forceinline__ int perm32(int rho) { const int n = rho >> 4, i = rho & 15; return 8 * (i >> 2) + 4 * n + (i & 3); }

struct Unit { int pm, pn, kind; };
struct Gemm { const bf16_t* A; const bf16_t* Bt; int M, N, K; const bf16_t* A1; const bf16_t* Bt1; const bf16_t* A2; const bf16_t* Bt2; };

struct StaticOrder {
    int nM, nN, nwg, G, c;
    __host__ __device__ __forceinline__ void init(int M, int N, int G_, int c_) { nM = M / BM; nN = N / BM; nwg = nM * nN; G = G_; c = c_; }
    __host__ __device__ __forceinline__ bool next(int i, Unit& u) const {
        const long L = (long)i * G + c; if (L >= nwg) return false;
        int wgid = (int)L; { const int q = nwg / NXCD, r = nwg % NXCD, xcd = wgid % NXCD, off = wgid / NXCD; wgid = (xcd < r ? xcd * (q + 1) : r * (q + 1) + (xcd - r) * q) + off; }
        const int nig = WGM * nN, gid = wgid / nig, fm = gid * WGM, gsz = (nM - fm) < WGM ? (nM - fm) : WGM;
        u.pm = fm + ((wgid % nig) % gsz); u.pn = (wgid % nig) / gsz; u.kind = 0; return true;
    }
    __device__ __forceinline__ void a_ready(const Unit&) const {}
    __device__ __forceinline__ void done(const Unit&) const {}
};

__device__ __forceinline__ unsigned cvt_pk_bf16(float lo, float hi) { unsigned r; asm volatile("v_cvt_pk_bf16_f32 %0, %1, %2" : "=v"(r) : "v"(lo), "v"(hi)); return r; }
template <class Epi, class Sched, bool ALIGN_EPI = false, bool SP2 = false>
__device__ __forceinline__ void gemm_phase(PG8_LAS unsigned char* lds, const Gemm g, const Sched& S, const Epi& E) {
    int tid_ = threadIdx.x; asm volatile("" : "+v"(tid_)); const int tid = tid_, wid = __builtin_amdgcn_readfirstlane(tid >> 6), lane = tid & 63, wr = wid >> 2, wc = wid & 3, fr = lane & 15, fq = lane >> 4;
    const int K = g.K, nt = K / BK;
    unsigned voffA[2], voffB[2];
#pragma unroll
    for (int i = 0; i < 2; ++i) { int R, C; stage_rc(tid * 16 + i * 8192, R, C); const int Rb = Epi::PERM ? ((R & ~31) + perm32(R & 31)) : R;
        voffA[i] = (unsigned)(R * K + C) * 2u; voffB[i] = (unsigned)(Rb * K + C) * 2u; }
    const size_t kstep = (size_t)(BK * 2);
    const size_t hstep = (size_t)HALF * K * 2;
    const size_t tstep = 2 * hstep;
    const unsigned ldsw = (unsigned)wid * 1024u;
    const int aoff = lds_byte(wr * 64 + fr, fq * 8), boff = lds_byte(wc * 32 + fr, fq * 8);
#define PG8_SA(b, h) (((b) * 2 + (h)) * HTB)
#define PG8_SB(b, h) ((4 + (b) * 2 + (h)) * HTB)
#define PG8_STAGE(bufoff, gbase, voff) do { _Pragma("unroll") for (int _i = 0; _i < 2; ++_i) \
        __builtin_amdgcn_global_load_lds((const unsigned*)((const char*)(gbase) + (voff)[_i]), (PG8_LAS unsigned*)(lds + (bufoff) + ldsw + _i * 8192), 16, 0, 0); } while (0)
#define PG8_LDA(dst, b, h) do { _Pragma("unroll") for (int m = 0; m < 4; ++m) _Pragma("unroll") for (int k = 0; k < 2; ++k) dst[m][k] = *(const PG8_LAS bf16x8*)(lds + PG8_SA(b, h) + aoff + m * 2048 + k * 1024); } while (0)
#define PG8_LDB(dst, b, h) do { _Pragma("unroll") for (int n = 0; n < 2; ++n) _Pragma("unroll") for (int k = 0; k < 2; ++k) dst[n][k] = *(const PG8_LAS bf16x8*)(lds + PG8_SB(b, h) + boff + n * 2048 + k * 1024); } while (0)
#define PG8_MMA(ai, bj, At, Bt) do { __builtin_amdgcn_s_setprio(1); _Pragma("unroll") for (int m = 0; m < 4; ++m) _Pragma("unroll") for (int n = 0; n < 2; ++n) _Pragma("unroll") for (int k = 0; k < 2; ++k) \
        acc[ai][bj][m][n] = __builtin_amdgcn_mfma_f32_16x16x32_bf16(Bt[n][k], At[m][k], acc[ai][bj][m][n], 0, 0, 0); __builtin_amdgcn_s_setprio(0); } while (0)
#define PG8_WAIT_V(n) asm volatile("s_waitcnt vmcnt(" #n ")" ::: "memory")
#define PG8_WAIT_L(n) asm volatile("s_waitcnt lgkmcnt(" #n ")" ::: "memory")
#define PG8_BAR __builtin_amdgcn_s_barrier()
#define PG8_SCHED __builtin_amdgcn_sched_barrier(0)
    Unit cur, nxt; int ui = 0;
    if (!S.next(0, cur)) return;
    f32x4 acc[2][2][4][2];
#pragma unroll
    for (int a = 0; a < 2; ++a)
#pragma unroll
        for (int b = 0; b < 2; ++b)
#pragma unroll
            for (int m = 0; m < 4; ++m)
#pragma unroll
                for (int n = 0; n < 2; ++n) acc[a][b][m][n] = (f32x4){0.f, 0.f, 0.f, 0.f};
    bf16x8 At[4][2], B0[2][2], B1[2][2];
    const char* cA = (const char*)(cur.kind == 0 ? g.A : (cur.kind == 1 ? g.A1 : g.A2)) + (size_t)cur.pm * tstep; const char* cB = (const char*)(cur.kind == 0 ? g.Bt : (cur.kind == 1 ? g.Bt1 : g.Bt2)) + (size_t)cur.pn * tstep;
    S.a_ready(cur);
    if constexpr (SP2) {
        PG8_STAGE(PG8_SB(0, 0), cB, voffB); PG8_STAGE(PG8_SB(0, 1), cB + hstep, voffB); PG8_STAGE(PG8_SA(0, 0), cA, voffA); PG8_STAGE(PG8_SA(0, 1), cA + hstep, voffA);
        if (wr == 1) PG8_BAR;
        PG8_WAIT_V(2); PG8_BAR;
        PG8_STAGE(PG8_SB(1, 0), cB + kstep, voffB); PG8_STAGE(PG8_SA(1, 0), cA + kstep, voffA); PG8_STAGE(PG8_SB(1, 1), cB + hstep + kstep, voffB);
        PG8_WAIT_V(6); PG8_BAR;
    } else {
        PG8_STAGE(PG8_SB(0, 0), cB, voffB); PG8_STAGE(PG8_SA(0, 0), cA, voffA); PG8_STAGE(PG8_SB(0, 1), cB + hstep, voffB); PG8_STAGE(PG8_SA(0, 1), cA + hstep, voffA);
        if (wr == 1) PG8_BAR;
        PG8_WAIT_V(4); PG8_BAR;
        PG8_STAGE(PG8_SB(1, 0), cB + kstep, voffB); PG8_STAGE(PG8_SA(1, 0), cA + kstep, voffA); PG8_STAGE(PG8_SB(1, 1), cB + hstep + kstep, voffB);
        PG8_WAIT_V(6); PG8_BAR;
    }
    for (;;) {
        const bool has_next = S.next(ui + 1, nxt);
        const char* nA = has_next ? (const char*)(nxt.kind == 0 ? g.A : (nxt.kind == 1 ? g.A1 : g.A2)) + (size_t)nxt.pm * tstep : cA; const char* nB = has_next ? (const char*)(nxt.kind == 0 ? g.Bt : (nxt.kind == 1 ? g.Bt1 : g.Bt2)) + (size_t)nxt.pn * tstep : cB;
        for (int t = 0; t < nt; t += 2) {
            const bool last = (t == nt - 2);
            const char* a1 = cA + (size_t)(t + 1) * kstep;
            const char* a2 = last ? nA : cA + (size_t)(t + 2) * kstep; const char* b2 = last ? nB : cB + (size_t)(t + 2) * kstep;
            const char* a3 = a2 + kstep; const char* b3 = b2 + kstep;
            if (last && has_next) S.a_ready(nxt);
            if constexpr (SP2) {
            PG8_LDB(B0, 0, 0); PG8_LDB(B1, 0, 1); PG8_SCHED; PG8_LDA(At, 0, 0); PG8_STAGE(PG8_SA(1, 1), a1 + hstep, voffA);
            PG8_WAIT_V(8); PG8_WAIT_L(0); PG8_BAR; PG8_MMA(0, 0, At, B0); PG8_MMA(0, 1, At, B1); PG8_BAR; PG8_SCHED;
            PG8_LDA(At, 0, 1); PG8_STAGE(PG8_SB(0, 0), b2, voffB); PG8_STAGE(PG8_SB(0, 1), b2 + hstep, voffB); PG8_STAGE(PG8_SA(0, 0), a2, voffA);
            PG8_WAIT_V(8); PG8_WAIT_L(0); PG8_BAR; PG8_MMA(1, 0, At, B0); PG8_MMA(1, 1, At, B1); PG8_BAR; PG8_SCHED;
            PG8_LDB(B0, 1, 0); PG8_LDB(B1, 1, 1); PG8_SCHED; PG8_LDA(At, 1, 0); PG8_STAGE(PG8_SA(0, 1), a2 + hstep, voffA);
            PG8_WAIT_V(8); PG8_WAIT_L(0); PG8_BAR; PG8_MMA(0, 0, At, B0); PG8_MMA(0, 1, At, B1); PG8_BAR; PG8_SCHED;
            PG8_LDA(At, 1, 1); PG8_STAGE(PG8_SB(1, 0), b3, voffB); PG8_STAGE(PG8_SB(1, 1), b3 + hstep, voffB); PG8_STAGE(PG8_SA(1, 0), a3, voffA);
            PG8_WAIT_V(8); PG8_WAIT_L(0); PG8_BAR; PG8_MMA(1, 0, At, B0); PG8_MMA(1, 1, At, B1); PG8_BAR; PG8_SCHED;
            } else {
            PG8_LDB(B0, 0, 0); PG8_SCHED; PG8_LDA(At, 0, 0); PG8_STAGE(PG8_SA(1, 1), a1 + hstep, voffA);
            PG8_WAIT_L(8); PG8_BAR; PG8_WAIT_L(0); PG8_MMA(0, 0, At, B0); PG8_BAR; PG8_SCHED;
            PG8_LDB(B1, 0, 1); PG8_STAGE(PG8_SB(0, 0), b2, voffB);
            PG8_BAR; PG8_WAIT_L(0); PG8_MMA(0, 1, At, B1); PG8_BAR;
            PG8_LDA(At, 0, 1); PG8_STAGE(PG8_SA(0, 0), a2, voffA);
            PG8_BAR; PG8_WAIT_L(0); PG8_MMA(1, 0, At, B0); PG8_BAR; PG8_SCHED;
            PG8_STAGE(PG8_SB(0, 1), b2 + hstep, voffB);
            PG8_WAIT_V(6); PG8_BAR; PG8_MMA(1, 1, At, B1); PG8_BAR;
            PG8_LDB(B0, 1, 0); PG8_SCHED; PG8_LDA(At, 1, 0); PG8_STAGE(PG8_SA(0, 1), a2 + hstep, voffA);
            PG8_WAIT_L(8); PG8_BAR; PG8_WAIT_L(0); PG8_MMA(0, 0, At, B0); PG8_BAR; PG8_SCHED;
            PG8_LDB(B1, 1, 1); PG8_STAGE(PG8_SB(1, 0), b3, voffB);
            PG8_BAR; PG8_WAIT_L(0); PG8_MMA(0, 1, At, B1); PG8_BAR;
            PG8_LDA(At, 1, 1); PG8_STAGE(PG8_SA(1, 0), a3, voffA);
            PG8_BAR; PG8_WAIT_L(0); PG8_MMA(1, 0, At, B0); PG8_BAR; PG8_SCHED;
            PG8_STAGE(PG8_SB(1, 1), b3 + hstep, voffB);
            PG8_WAIT_V(6); PG8_BAR; PG8_MMA(1, 1, At, B1); PG8_BAR;
            }
        }
        if constexpr (ALIGN_EPI) { if (wr == 0) PG8_BAR; }
        if constexpr (!Epi::AFTER_DRAIN) { E(acc, cur, wr, wc, fr, fq); S.done(cur); }
        if (!has_next) break;
#pragma unroll
        for (int a = 0; a < 2; ++a)
#pragma unroll
            for (int b = 0; b < 2; ++b)
#pragma unroll
                for (int m = 0; m < 4; ++m)
#pragma unroll
                    for (int n = 0; n < 2; ++n) acc[a][b][m][n] = (f32x4){0.f, 0.f, 0.f, 0.f};
        cur = nxt; cA = nA; cB = nB; ++ui;
        if constexpr (ALIGN_EPI) { if (wr == 1) PG8_BAR; }
    }
    PG8_WAIT_V(0);
    if constexpr (!ALIGN_EPI) { if (wr == 0) PG8_BAR; }
    PG8_BAR;
    if constexpr (Epi::AFTER_DRAIN) { E.fused(acc, cur, wr, wc, fr, fq, lds, wid, lane); S.done(cur); }
#undef PG8_SA
#undef PG8_SB
#undef PG8_STAGE
#undef PG8_LDA
#undef PG8_LDB
#undef PG8_MMA
#undef PG8_WAIT_V
#undef PG8_WAIT_L
#undef PG8_BAR
#undef PG8_SCHED
}
}

#define LAS __attribute__((address_space(3)))
using pg8::Unit; using pg8::f32x4; using pg8::bf16x8; using pg8::bf16_t; using pg8::u32x4;
typedef float f32x16 __attribute__((ext_vector_type(16)));
typedef unsigned u32x2 __attribute__((ext_vector_type(2)));
typedef float f32x2_t __attribute__((ext_vector_type(2)));
typedef __bf16 bf16x2_t __attribute__((ext_vector_type(2)));

constexpr int NBATCH = 8, TOK = 2304, NROW = NBATCH * TOK, DM = 1024;
constexpr float LOG2E = 1.4426950408889634f, QS = 0.125f * 1.4426950408889634f;
constexpr size_t MiB = 1u << 20;
constexpr size_t WS_TAB = 0, WS_W = 2 * MiB, WS_HN = 22 * MiB, WS_AQ = 58 * MiB, WS_AK = 76 * MiB, WS_AVT = 80 * MiB + MiB / 2, WS_SAG = 85 * MiB, WS_SCG = 103 * MiB,
                 WS_BU = 121 * MiB, WS_SBG = 139 * MiB, WS_CQ = 157 * MiB, WS_CK = 175 * MiB, WS_CVT = 193 * MiB, WS_SC = 211 * MiB, WS_H1C = 229 * MiB, WS_MCTX = 237 * MiB  , WS_END = 255 * MiB;
constexpr size_t WS_E0 = 237 * MiB;
constexpr size_t WS_MB2 = 211 * MiB;
constexpr size_t WS_YBUF = WS_SAG  , WS_YO = WS_BU  , WS_MBUF = WS_CK  , WS_YBF = WS_BU  ;
constexpr size_t W_IN = 0, W_OA = (size_t)7424 * 1024, W_OB = W_OA + 1024 * 512, W_OC = W_OB + 1024 * 512, W_OUT = W_OC + 1024 * 512, W_GLU = W_OUT + 1024 * 1024;
constexpr size_t T_MOD = 0, T_ROPE = 221184, T_LAM = 229376, T_BBT = 229632, T_AP = 753920, T_CC = 950528;
constexpr int LDS_BYTES = 147456;
constexpr size_t WS_BAR = 1572864;
constexpr int LDS_MISC = 147456 - 512;

struct Args { const float* in[29]; float* out; unsigned char* ws; int ph_lo, ph_hi; };
enum { I_X = 0, I_C, I_CTX, I_CCTX, I_WMOD, I_BMOD, I_NPRE, I_NPOST, I_WIN, I_SINK, I_ARE, I_AIM, I_LOGDT, I_BRE, I_BIM, I_CRE, I_CIM, I_SD, I_WGLU, I_BGLU,
       I_LQ1, I_LK1, I_LQ2, I_LK2, I_SUBLN, I_WOA, I_WOB, I_WOC, I_WOUT };

__device__ __forceinline__ unsigned pk2(float lo, float hi) { f32x2_t v = {lo, hi}; bf16x2_t b = __builtin_convertvector(v, bf16x2_t); return __builtin_bit_cast(unsigned, b); }
__device__ __forceinline__ bf16_t f2bf(float f) { return (bf16_t)(pk2(f, 0.f) & 0xffffu); }
__device__ __forceinline__ float bf2f(unsigned short h) { return __builtin_bit_cast(float, (unsigned)h << 16); }
__device__ __forceinline__ float bflo(unsigned w) { return __builtin_bit_cast(float, w << 16); }
__device__ __forceinline__ float bfhi(unsigned w) { return __builtin_bit_cast(float, w & 0xffff0000u); }
__device__ __forceinline__ void store8(bf16_t* p, const float (&v)[8]) { u32x4 w; w.x = pk2(v[0], v[1]); w.y = pk2(v[2], v[3]); w.z = pk2(v[4], v[5]); w.w = pk2(v[6], v[7]); *(u32x4*)p = w; }
__device__ __forceinline__ void load8(const bf16_t* p, float (&v)[8]) { const u32x4 w = *(const u32x4*)p; v[0] = bflo(w.x); v[1] = bfhi(w.x); v[2] = bflo(w.y); v[3] = bfhi(w.y); v[4] = bflo(w.z); v[5] = bfhi(w.z); v[6] = bflo(w.w); v[7] = bfhi(w.w); }
#define LOG2E_ 1.4426950408889634f
__device__ __forceinline__ float sigmoidf_(float x) { return __builtin_amdgcn_rcpf(1.f + __builtin_amdgcn_exp2f(-LOG2E_ * x)); }
__device__ __forceinline__ float siluf_(float x) { return x * __builtin_amdgcn_rcpf(1.f + __builtin_amdgcn_exp2f(-LOG2E_ * x)); }
__device__ __forceinline__ float gelu_tanh(float x) { const float u = 0.7978845608028654f * (x + 0.044715f * x * x * x); const float t = 1.f - 2.f * __builtin_amdgcn_rcpf(1.f + __builtin_amdgcn_exp2f(2.f * LOG2E_ * u)); return 0.5f * x * (1.f + t); }
__device__ __forceinline__ float wave_sum(float v) {
#pragma unroll
    for (int o = 1; o < 64; o <<= 1) v += __shfl_xor(v, o);
    return v;
}
__device__ __forceinline__ float xhalf_max(float x) { auto rr = __builtin_amdgcn_permlane32_swap(__float_as_uint(x), __float_as_uint(x), false, false); return fmaxf(__uint_as_float(rr[0]), __uint_as_float(rr[1])); }
__device__ __forceinline__ float xhalf_other(float x, int hh) { auto rr = __builtin_amdgcn_permlane32_swap(__float_as_uint(x), __float_as_uint(x), false, false); return __uint_as_float(hh ? rr[0] : rr[1]); }
__device__ __forceinline__ f32x16 mfma32(bf16x8 a, bf16x8 b, f32x16 c) { return __builtin_amdgcn_mfma_f32_32x32x16_bf16(a, b, c, 0, 0, 0); }
__device__ __forceinline__ f32x4 mfma16(bf16x8 a, bf16x8 b, f32x4 c) { return __builtin_amdgcn_mfma_f32_16x16x32_bf16(a, b, c, 0, 0, 0); }
__device__ __forceinline__ f32x16 zero16() { f32x16 z;
#pragma unroll
    for (int i = 0; i < 16; ++i) z[i] = 0.f; return z; }

#define EPI_V8(v, acc, ai, bj, m) float v[8] = {acc[ai][bj][m][0][0], acc[ai][bj][m][0][1], acc[ai][bj][m][0][2], acc[ai][bj][m][0][3], acc[ai][bj][m][1][0], acc[ai][bj][m][1][1], acc[ai][bj][m][1][2], acc[ai][bj][m][1][3]}

struct EpiIn {
    static constexpr bool PERM = true, AFTER_DRAIN = false;
    unsigned char* ws; const float2* rope;
    __device__ __forceinline__ void operator()(const f32x4 (&acc)[2][2][4][2], const Unit& u, int wr, int wc, int fr, int fq) const {
        const int b = u.pm / 9, tq = u.pm % 9; const bool lat = tq != 0;
#pragma unroll
        for (int bj = 0; bj < 2; ++bj) {
            const int gt = u.pn * 2 + bj, cb = gt * 128 + wc * 32 + 8 * fq;
            int type, lc, pitch; size_t off;
            if (gt < 4) { type = 1; off = WS_AQ; lc = cb; pitch = 512; }
            else if (gt == 4) { type = 2; off = WS_AK; lc = cb - 512; pitch = 128; }
            else if (gt == 5) { type = 3; off = WS_AVT; lc = cb - 640; pitch = 128; }
            else if (gt < 10) { type = 4; off = WS_SAG; lc = cb - 768; pitch = 512; }
            else if (gt < 14) { type = 0; off = WS_BU; lc = cb - 1280; pitch = 512; }
            else if (gt < 18) { type = 4; off = WS_SBG; lc = cb - 1792; pitch = 512; }
            else if (gt < 22) { type = 1; off = WS_CQ; lc = cb - 2304; pitch = 512; }
            else if (gt < 26) { type = 2; off = WS_CK; lc = cb - 2816; pitch = 512; }
            else if (gt < 30) { type = 3; off = WS_CVT; lc = cb - 3328; pitch = 512; }
            else { type = 4; off = WS_SCG; lc = cb - 3840; pitch = 512; }
            bf16_t* dst = (bf16_t*)(ws + off);
            if (type == 1 || type == 2) {
                const float qsc = type == 1 ? QS : 1.f;
#pragma unroll
                for (int o = 0; o < (lat ? 1 : 0); ++o) {
                    if (wc & 1) {
#pragma unroll
                        for (int m = 0; m < 4; ++m) { const float2* rp = rope + (m * 16 + fr) * 16 + 8 * (fq & 1); float2 cs[8];
#pragma unroll
                            for (int i = 0; i < 8; ++i) cs[i] = rp[i];
#pragma unroll
                            for (int ai = 0; ai < 2; ++ai) { const int tau = tq * 256 + ai * 128 + wr * 64 + m * 16 + fr; const size_t row = (size_t)b * TOK + tau; EPI_V8(v, acc, ai, bj, m);
#pragma unroll
                                for (int i = 0; i < 8; ++i) { const float p = xhalf_other(v[i], fq >> 1); v[i] = (v[i] * cs[i].x + (fq >= 2 ? p : -p) * cs[i].y) * qsc; }
                                store8(dst + row * pitch + lc, v); } }
                    } else {
#pragma unroll
                        for (int ai = 0; ai < 2; ++ai) { const float2* rp = rope + ((tq - 1) * 4 + ai * 2 + wr) * 16 + 8 * (fq & 1); float2 cs[8];
#pragma unroll
                            for (int i = 0; i < 8; ++i) cs[i] = rp[i];
#pragma unroll
                            for (int m = 0; m < 4; ++m) { const int tau = tq * 256 + ai * 128 + wr * 64 + m * 16 + fr; const size_t row = (size_t)b * TOK + tau; EPI_V8(v, acc, ai, bj, m);
#pragma unroll
                                for (int i = 0; i < 8; ++i) { const float p = xhalf_other(v[i], fq >> 1); v[i] = (v[i] * cs[i].x + (fq >= 2 ? p : -p) * cs[i].y) * qsc; }
                                store8(dst + row * pitch + lc, v); } }
                    }
                }
                if (!lat) {
#pragma unroll
                    for (int ai = 0; ai < 2; ++ai)
#pragma unroll
                        for (int m = 0; m < 4; ++m) { const int tau = tq * 256 + ai * 128 + wr * 64 + m * 16 + fr; const size_t row = (size_t)b * TOK + tau; EPI_V8(v, acc, ai, bj, m);
#pragma unroll
                            for (int i = 0; i < 8; ++i) v[i] *= qsc;
                            store8(dst + row * pitch + lc, v); }
                }
            } else {
#pragma unroll
            for (int ai = 0; ai < 2; ++ai)
#pragma unroll
                for (int m = 0; m < 4; ++m) {
                    const int tau = tq * 256 + ai * 128 + wr * 64 + m * 16 + fr; const size_t row = (size_t)b * TOK + tau;
                    EPI_V8(v, acc, ai, bj, m);
                    if (type == 3) {
#pragma unroll
                        for (int i = 0; i < 8; ++i) dst[((size_t)b * pitch + lc + i) * TOK + tau] = f2bf(v[i]);
                    } else {
                        if (type == 4) {
#pragma unroll
                            for (int i = 0; i < 8; ++i) v[i] = siluf_(v[i]);
                        }
                        store8(dst + row * pitch + lc, v);
                    }
                }
            }
        }
    }
};
template <int MODE> struct EpiRow {
    static constexpr bool PERM = true, AFTER_DRAIN = false;
    bf16_t* O; int ldc; const bf16_t* X; const float* bias; const bf16_t* XC; int xcoff; bool octx; bool cfirst; unsigned char* wsm; bool bykind; bool two;
    __device__ __forceinline__ void operator()(const f32x4 (&acc)[2][2][4][2], const Unit& u, int wr, int wc, int fr, int fq) const {
        const bool ctxt = (u.pm % 9) == 0; const size_t crow0 = (size_t)(u.pm / 9) * 2048;
        const int xco = bykind ? (u.kind == 0 ? 1024 : (u.kind == 1 ? 0 : 2048)) : xcoff; const bool cf = bykind ? (u.kind == 0) : cfirst;
        const size_t mboff = (two && u.kind == 1) ? WS_MB2 : WS_MBUF; const bool skipy_all = two && u.kind == 0;
#pragma unroll
        for (int ai = 0; ai < 2; ++ai)
#pragma unroll
            for (int m = 0; m < 4; ++m) {
                const size_t row = (size_t)u.pm * 256 + ai * 128 + wr * 64 + m * 16 + fr;
#pragma unroll
                for (int bj = 0; bj < 2; ++bj) {
                    const int col = u.pn * 256 + bj * 128 + wc * 32 + 8 * fq; const size_t o = (MODE == 1 && octx ? row - crow0 : row) * ldc + col;
                    bf16_t* mp = (bf16_t*)(wsm + mboff) + row * 1024 + col;
                    EPI_V8(v, acc, ai, bj, m);
                    if (MODE == 1) {
#pragma unroll
                        for (int i = 0; i < 8; ++i) v[i] = sigmoidf_(v[i]);
                    } else if (MODE == 2 || MODE == 3) {
                        float mb[8]; load8((XC != nullptr && ctxt) ? XC + (row - crow0) * 3072 + xco + col : (const bf16_t*)mp, mb);
                        if (MODE == 3 && !(cf && ctxt) && !skipy_all) { float y[8]; load8(O + o, y);
#pragma unroll
                            for (int i = 0; i < 8; ++i) v[i] = y[i] + mb[i] * v[i];
                        } else {
#pragma unroll
                            for (int i = 0; i < 8; ++i) v[i] = mb[i] * v[i];
                        }
                    } else if (MODE == 4) {
                        float yb[8], sg[8]; load8(X + o, yb); load8(O + o, sg); const f32x4 b0 = *(const f32x4*)(bias + col), b1 = *(const f32x4*)(bias + col + 4);
                        const float bb[8] = {b0[0], b0[1], b0[2], b0[3], b1[0], b1[1], b1[2], b1[3]};
#pragma unroll
                        for (int i = 0; i < 8; ++i) v[i] = yb[i] * sigmoidf_(v[i] + bb[i]) * sg[i];
                    }
                    store8((MODE == 1 && !octx) ? mp : O + o, v);
                }
            }
    }
};
struct FlexOrder {
    pg8::StaticOrder s; int mode, nlat, nN, G, c, i0;
    __device__ __forceinline__ void init(int N, int G_, int c_, int mode_) { mode = mode_; nN = N / 256; nlat = 64 * nN; G = G_; c = c_; s.init(mode_ == 0 ? NROW : 16384, N, G_, c_);
        i0 = 0; if (mode_ == 4 || mode_ == 5) { i0 = (nlat - c_ + G_ - 1) / G_; if (i0 < 0) i0 = 0; } if (mode_ == 3) { c = ((c_ - (G_ == 256 ? 32 : 144)) % G_ + G_) % G_; } }
    __device__ __forceinline__ bool next(int i, Unit& u) const {
        u.kind = 0;
        if (mode == 0) return s.next(i, u);
        if (mode == 3) { const long e = (long)i * G + c; if (e >= 8 * nN) return false; u.pm = 9 * (int)(e / nN); u.pn = (int)(e % nN); return true; }
        if (mode == 6) { if (!s.next(i >> 1, u)) return false; u.pm = (u.pm >> 3) * 9 + 1 + (u.pm & 7); u.kind = i & 1; return true; }
        if (mode == 5) { const long L5 = (long)(i / 3 + i0) * G + c; const int e = (int)(L5 - nlat); if (e < 0 || e >= 8 * nN) return false; u.pm = 9 * (e / nN); u.pn = e % nN; u.kind = i % 3; return true; }
        const long L = (long)(i + i0) * G + c;
        if (mode == 1 || (mode == 2 && L < nlat)) { if (!s.next(i, u)) return false; u.pm = (u.pm >> 3) * 9 + 1 + (u.pm & 7); return true; }
        const int e = (int)(L - nlat); if (e < 0 || e >= 8 * nN) return false;
        u.pm = 9 * (e / nN); u.pn = e % nN; return true;
    }
    __device__ __forceinline__ void a_ready(const Unit&) const {}
    __device__ __forceinline__ void done(const Unit&) const {}
};
__device__ __forceinline__ void transpose_item(const float* W, int K, int N, bf16_t* WT, LAS float* scr, int item, int lane) {
    const int nblk = N / 32, kb = item / nblk, nb = item % nblk, k0 = 64 * kb, n0 = 32 * nb;
#pragma unroll 8
    for (int i = 0; i < 32; ++i) { const int kk = 2 * i + (lane >> 5); scr[kk * 33 + (lane & 31)] = W[(size_t)(k0 + kk) * N + n0 + (lane & 31)]; }
    asm volatile("s_waitcnt lgkmcnt(0)" ::: "memory");
    const int c = lane & 7;
#pragma unroll
    for (int j = 0; j < 4; ++j) { const int n = (lane >> 3) + 8 * j; const LAS float* s = scr + (8 * c) * 33 + n;
        u32x4 o; o.x = pk2(s[0 * 33], s[1 * 33]); o.y = pk2(s[2 * 33], s[3 * 33]); o.z = pk2(s[4 * 33], s[5 * 33]); o.w = pk2(s[6 * 33], s[7 * 33]);
        *(u32x4*)(WT + (size_t)(n0 + n) * K + k0 + 8 * c) = o; }
    asm volatile("s_waitcnt lgkmcnt(0)" ::: "memory");
}
__device__ __forceinline__ void weights_layer(const Args& a, int l, LAS unsigned char* lds, int gw, int ngw, int wave, int lane, int part  ) {
    LAS float* scr = (LAS float*)(lds + wave * 16384);
    bf16_t* W = (bf16_t*)(a.ws + WS_W);
    constexpr int I_IN = 16 * 232, I_O = 8 * 32, I_OUT = 16 * 32, I_G = 8 * 16, NIT = I_IN + 3 * I_O + I_OUT + I_G;
    for (int it = gw; it < NIT; it += ngw) {
        int r = it;
        if (part == 1 && (r < I_IN + 3 * I_O || r >= I_IN + 3 * I_O + I_OUT)) continue;
        if (r < I_IN) { transpose_item(a.in[I_WIN] + (size_t)l * 1024 * 7424, 1024, 7424, W + W_IN, scr, r, lane); continue; } r -= I_IN;
        if (r < I_O) { transpose_item(a.in[I_WOA] + (size_t)l * 512 * 1024, 512, 1024, W + W_OA, scr, r, lane); continue; } r -= I_O;
        if (r < I_O) { transpose_item(a.in[I_WOB] + (size_t)l * 512 * 1024, 512, 1024, W + W_OB, scr, r, lane); continue; } r -= I_O;
        if (r < I_O) { transpose_item(a.in[I_WOC] + (size_t)l * 512 * 1024, 512, 1024, W + W_OC, scr, r, lane); continue; } r -= I_O;
        if (r < I_OUT) { if (part != 0) transpose_item(a.in[I_WOUT] + (size_t)l * 1024 * 1024, 1024, 1024, W + W_OUT, scr, r, lane); continue; } r -= I_OUT;
        if (part == 1) continue;
        transpose_item(a.in[I_WGLU] + (size_t)l * 512 * 512, 512, 512, W + W_GLU, scr, r, lane);
    }
}
__device__ __forceinline__ const float* h_src(const Args& a, int layer, int b, int tau) {
    if (layer == 0) return tau < 256 ? a.in[I_CTX] + ((size_t)b * 256 + tau) * DM : a.in[I_X] + ((size_t)b * 2048 + tau - 256) * DM;
    return tau < 256 ? (const float*)(a.ws + WS_H1C) + ((size_t)b * 256 + tau) * DM : a.out + ((size_t)b * 2048 + tau - 256) * DM;
}
__device__ __forceinline__ void hn_store(const f32x4 (&v)[4], const float* mod, const float* nw, bf16_t* dst, int lane) {
    float ss = 0.f;
#pragma unroll
    for (int j = 0; j < 4; ++j) ss += (v[j][0] * v[j][0] + v[j][1] * v[j][1]) + (v[j][2] * v[j][2] + v[j][3] * v[j][3]);
    const float r = 1.f / sqrtf(wave_sum(ss) * (1.f / DM) + 1e-6f);
#pragma unroll
    for (int j = 0; j < 4; ++j) { const int c = 4 * (lane + 64 * j); const f32x4 w = *(const f32x4*)(nw + c), sh = *(const f32x4*)(mod + c), sc = *(const f32x4*)(mod + 1024 + c);
        const f32x4 o = v[j] * r * w * (1.f + sc) + sh; u32x2 pk; pk.x = pk2(o[0], o[1]); pk.y = pk2(o[2], o[3]); *(u32x2*)(dst + c) = pk; }
}

__device__ __forceinline__ void phase_p0(const Args& a, LAS unsigned char* lds, int tid, int wave, int lane) {
    const float* c = a.in[I_C]; const float* cctx = a.in[I_CCTX];
    float* MOD = (float*)(a.ws + WS_TAB + T_MOD);
    for (int vb = blockIdx.x; vb < 210; vb += gridDim.x) {
        if (vb < 192) {
            const int l = vb / 96, n0 = (vb % 96) * 32;
            LAS float* sc = (LAS float*)lds; LAS float* red = sc + 9 * 1024;
            for (int i = tid; i < 9 * 1024; i += 512) { const float v = i < 8192 ? c[i] : cctx[i - 8192]; sc[i] = v / (1.f + expf(-v)); }
            __syncthreads();
            const int s = tid >> 5, nn = tid & 31; float acc[9];
#pragma unroll
            for (int j = 0; j < 9; ++j) acc[j] = 0.f;
            const float* wp = a.in[I_WMOD] + ((size_t)l * 1024 + s * 64) * 3072 + n0 + nn;
#pragma unroll 16
            for (int k = 0; k < 64; ++k) { const float w = wp[(size_t)k * 3072];
#pragma unroll
                for (int j = 0; j < 9; ++j) acc[j] += sc[j * 1024 + s * 64 + k] * w; }
#pragma unroll
            for (int j = 0; j < 9; ++j) red[(s * 9 + j) * 32 + nn] = acc[j];
            __syncthreads();
            if (tid < 288) { const int j = tid >> 5; float t = a.in[I_BMOD][l * 3072 + n0 + nn];
#pragma unroll
                for (int s2 = 0; s2 < 16; ++s2) t += red[(s2 * 9 + j) * 32 + nn];
                MOD[(l * 9 + j) * 3072 + n0 + nn] = t; }
            __syncthreads();
        } else if (vb < 208) {
            const int idx = (vb - 192) * 512 + tid, l = idx >> 12, dir = (idx >> 11) & 1, g = (idx >> 6) & 31, p = idx & 63;
            const int ld = l * 2 + dir;
            const double dt = exp((double)a.in[I_LOGDT][ld * 32 + g]);
            const double are = a.in[I_ARE][(ld * 32 + g) * 64 + p], aim = a.in[I_AIM][(ld * 32 + g) * 64 + p];
            const double mag = exp(are * dt), abr = mag * cos(aim * dt), abi = mag * sin(aim * dt);
            const double den = are * are + aim * aim, nr = abr - 1.0, ni = abi;
            const double fre = (nr * are + ni * aim) / den, fim = (ni * are - nr * aim) / den;
            bf16_t* BbT = (bf16_t*)(a.ws + WS_TAB + T_BBT) + (size_t)(ld * 32 + g) * 2048;
            const float* bre = a.in[I_BRE] + ((size_t)(ld * 32 + g) * 64 + p) * 16; const float* bim = a.in[I_BIM] + ((size_t)(ld * 32 + g) * 64 + p) * 16;
            for (int h = 0; h < 16; ++h) { const double br = bre[h], bi = bim[h];
                BbT[(0 * 64 + p) * 16 + h] = f2bf((float)(fre * br - fim * bi)); BbT[(1 * 64 + p) * 16 + h] = f2bf((float)(fre * bi + fim * br)); }
            float* Ap = (float*)(a.ws + WS_TAB + T_AP) + (size_t)(ld * 32 + g) * 384;
#pragma unroll
            for (int k = 0; k < 3; ++k) { const double n = (k == 0 ? 1.0 : (k == 1 ? 16.0 : 32.0)), mg = exp(n * are * dt); Ap[(2 * k) * 64 + p] = (float)(mg * cos(n * aim * dt)); Ap[(2 * k + 1) * 64 + p] = (float)(mg * sin(n * aim * dt)); }
            bf16_t* Cc = (bf16_t*)(a.ws + WS_TAB + T_CC) + (size_t)(ld * 32 + g) * 2048;
            const float* cre = a.in[I_CRE] + (size_t)(ld * 32 + g) * 1024; const float* cim = a.in[I_CIM] + (size_t)(ld * 32 + g) * 1024;
            const int pl = p & 31, pb = p >> 5;
            for (int h = 0; h < 16; ++h) { Cc[h * 128 + 4 * pl + 2 * pb] = f2bf(cre[h * 64 + p]); Cc[h * 128 + 4 * pl + 2 * pb + 1] = f2bf(-cim[h * 64 + p]); }
        } else if (vb == 208) {
            float2* rope = (float2*)(a.ws + WS_TAB + T_ROPE);
            for (int i = tid; i < 1024; i += 512) { const int pos = i >> 4, f = i & 15; const float inv = (float)pow(10000.0, -(double)f / 16.0); const float ang = (float)pos * inv;
                rope[i] = make_float2((float)cos((double)ang), (float)sin((double)ang)); }
        } else {
            if (tid < 2) { const int l = tid; float s1 = 0.f, s2 = 0.f;
                for (int i = 0; i < 64; ++i) { s1 += a.in[I_LQ1][l * 64 + i] * a.in[I_LK1][l * 64 + i]; s2 += a.in[I_LQ2][l * 64 + i] * a.in[I_LK2][l * 64 + i]; }
                const float lam_init = 0.8f - 0.6f * expf(-0.3f * (float)l);
                ((float*)(a.ws + WS_TAB + T_LAM))[l] = expf(s1) - expf(s2) + lam_init; }
        }
    }
    __syncthreads();
    weights_layer(a, 0, lds, blockIdx.x * 8 + wave, gridDim.x * 8, wave, lane, 2);
}
struct RowPar { f32x4 w[4], a[4], c[4]; };
__device__ __forceinline__ void load_prepar(RowPar& P, const float* mod, const float* nw, int lane) {
#pragma unroll
    for (int j = 0; j < 4; ++j) { const int c = 4 * (lane + 64 * j); P.w[j] = *(const f32x4*)(nw + c); P.a[j] = *(const f32x4*)(mod + c); P.c[j] = 1.f + *(const f32x4*)(mod + 1024 + c); }
}
__device__ __forceinline__ void hn_store_p(const f32x4 (&v)[4], const RowPar& P, bf16_t* dst, int lane) {
    float ss = 0.f;
#pragma unroll
    for (int j = 0; j < 4; ++j) ss += (v[j][0] * v[j][0] + v[j][1] * v[j][1]) + (v[j][2] * v[j][2] + v[j][3] * v[j][3]);
    const float r = 1.f / sqrtf(wave_sum(ss) * (1.f / DM) + 1e-6f);
#pragma unroll
    for (int j = 0; j < 4; ++j) { const int c = 4 * (lane + 64 * j); const f32x4 o = v[j] * r * P.w[j] * P.c[j] + P.a[j]; u32x2 pk; pk.x = pk2(o[0], o[1]); pk.y = pk2(o[2], o[3]); *(u32x2*)(dst + c) = pk; }
}
__device__ __forceinline__ void phase_hn0(const Args& a, int wave, int lane) {
    const float* MOD = (const float*)(a.ws + WS_TAB + T_MOD);
    const int gw = blockIdx.x * 8 + wave, wpb = (gridDim.x * 8) / 8, b = gw / wpb, r0 = gw % wpb;
    if (b >= 8) return;
    RowPar P; int cls = -1;
    int tau = r0;
    f32x4 vn[4];
    if (tau < TOK) { const f32x4* src = (const f32x4*)h_src(a, 0, b, tau);
#pragma unroll
        for (int j = 0; j < 4; ++j) vn[j] = src[lane + 64 * j]; }
    for (; tau < TOK; tau += wpb) {
        f32x4 v[4];
#pragma unroll
        for (int j = 0; j < 4; ++j) v[j] = vn[j];
        const int c = tau < 256 ? 1 : 0;
        if (c != cls) { load_prepar(P, MOD + (size_t)(c ? 8 : b) * 3072, a.in[I_NPRE], lane); cls = c; }
        const int tn = tau + wpb;
        if (tn < TOK) { const f32x4* src = (const f32x4*)h_src(a, 0, b, tn);
#pragma unroll
            for (int j = 0; j < 4; ++j) vn[j] = src[lane + 64 * j]; }
        hn_store_p(v, P, (bf16_t*)(a.ws + WS_HN) + ((size_t)b * TOK + tau) * DM, lane);
    }
}
__device__ __forceinline__ void phase_resid(const Args& a, int layer, LAS unsigned char* lds, int wave, int lane) {
    const float* MOD = (const float*)(a.ws + WS_TAB + T_MOD);
    const bf16_t* YO = (const bf16_t*)(a.ws + WS_YO);
    const float* npost = a.in[I_NPOST] + layer * DM;
    const int gw = blockIdx.x * 8 + wave, wpb = (gridDim.x * 8) / 8, b = gw / wpb, r0 = gw % wpb;
    if (b < 8) {
        RowPar Q, P; int cls = -1;
        int tau = r0;
        while (tau < TOK && layer == 1 && tau < 256) tau += wpb;
        f32x4 hn_[4]; u32x2 yn_[4];
        if (tau < TOK) { const f32x4* src = (const f32x4*)h_src(a, layer, b, tau); const size_t row = (size_t)b * TOK + tau;
#pragma unroll
            for (int j = 0; j < 4; ++j) { hn_[j] = src[lane + 64 * j]; yn_[j] = *(const u32x2*)(YO + row * DM + 4 * (lane + 64 * j)); } }
        while (tau < TOK) {
            const size_t row = (size_t)b * TOK + tau;
            f32x4 h[4], y[4]; float ss = 0.f;
#pragma unroll
            for (int j = 0; j < 4; ++j) { h[j] = hn_[j]; const u32x2 w = yn_[j];
                y[j] = (f32x4){bflo(w.x), bfhi(w.x), bflo(w.y), bfhi(w.y)}; ss += (y[j][0] * y[j][0] + y[j][1] * y[j][1]) + (y[j][2] * y[j][2] + y[j][3] * y[j][3]); }
            const int c = tau < 256 ? 1 : 0;
            if (c != cls) { const float* mod = MOD + (size_t)(layer * 9 + (c ? 8 : b)) * 3072;
#pragma unroll
                for (int j = 0; j < 4; ++j) { const int cc = 4 * (lane + 64 * j); Q.w[j] = *(const f32x4*)(npost + cc); Q.a[j] = *(const f32x4*)(mod + 2048 + cc); }
                if (layer == 0) load_prepar(P, MOD + (size_t)(9 + (c ? 8 : b)) * 3072, a.in[I_NPRE] + DM, lane);
                cls = c; }
            const int tn = tau + wpb;
            if (tn < TOK) { const f32x4* src = (const f32x4*)h_src(a, layer, b, tn); const size_t rn = (size_t)b * TOK + tn;
#pragma unroll
                for (int j = 0; j < 4; ++j) { hn_[j] = src[lane + 64 * j]; yn_[j] = *(const u32x2*)(YO + rn * DM + 4 * (lane + 64 * j)); } }
            f32x4* dst = (f32x4*)(tau < 256 ? (float*)(a.ws + WS_H1C) + ((size_t)b * 256 + tau) * DM : a.out + ((size_t)b * 2048 + tau - 256) * DM);
            const float r = 1.f / sqrtf(wave_sum(ss) * (1.f / DM) + 1e-6f);
#pragma unroll
            for (int j = 0; j < 4; ++j) { h[j] = h[j] + Q.a[j] * (y[j] * r * Q.w[j]); dst[lane + 64 * j] = h[j]; }
            if (layer == 0) hn_store_p(h, P, (bf16_t*)(a.ws + WS_HN) + row * DM, lane);
            tau = tn;
        }
    }
    if (layer == 0) { __syncthreads(); weights_layer(a, 1, lds, blockIdx.x * 8 + wave, gridDim.x * 8, wave, lane, 1); }
}

template <bool WIN>
__device__ __forceinline__ f32x16 attn_qk(const f32x16& negm, const bf16x8 (&qf)[4], const LAS unsigned char* kb, int mode, int ql, int hh) {
    bf16x8 kf[4];
#pragma unroll
    for (int d0 = 0; d0 < 4; ++d0) kf[d0] = *(const LAS bf16x8*)(kb + d0 * 32);
    f32x16 s = negm;
#pragma unroll
    for (int d0 = 0; d0 < 4; ++d0) s = mfma32(kf[d0], qf[d0], s);
    if (WIN) {
        if (mode != 0) {
#pragma unroll
            for (int r = 0; r < 16; ++r) { const int j = (r & 3) + 4 * ((r >> 2) & 1) + 8 * hh + 16 * (r >> 3); const bool ok = mode == 1 ? (j >= ql) : (j <= ql); if (!ok) s[r] = -INFINITY; }
        }
    }
    return s;
}
template <int NDB, int VP>
__device__ __forceinline__ void attn_pv(f32x16 (&o)[NDB], f32x16& negm, float& mref, float& lsum, int& first, f32x16& s, f32x16& s2, const LAS unsigned char* vb) {
    constexpr int NEARLY = NDB > 3 ? 3 : NDB;
    bf16x8 vf[NDB][2];
#pragma unroll
    for (int db = 0; db < NEARLY; ++db) { vf[db][0] = *(const LAS bf16x8*)(vb + db * 32 * VP); vf[db][1] = *(const LAS bf16x8*)(vb + db * 32 * VP + 32); }
    __builtin_amdgcn_sched_barrier(0);
    float mx = fmaxf(s[0], s[1]);
#pragma unroll
    for (int r = 2; r < 16; ++r) mx = fmaxf(mx, s[r]);
    mx = xhalf_max(mx);
    if (__any((first != 0) || (mx > 8.f))) {
        const float delta = first ? mx : fmaxf(mx, 0.f), alpha = first ? 1.f : __builtin_amdgcn_exp2f(-delta);
        mref += delta; lsum *= alpha;
#pragma unroll
        for (int r = 0; r < 16; ++r) { s[r] -= delta; s2[r] -= delta; negm[r] = -mref; }
#pragma unroll
        for (int db = 0; db < NDB; ++db) o[db] = o[db] * alpha;
        first = 0;
    }
    float ps = 0.f;
#pragma unroll
    for (int r = 0; r < 16; ++r) { s[r] = __builtin_amdgcn_exp2f(s[r]); ps += s[r]; }
    lsum += ps;
    u32x4 w0, w1; w0.x = pk2(s[0], s[1]); w0.y = pk2(s[2], s[3]); w0.z = pk2(s[4], s[5]); w0.w = pk2(s[6], s[7]);
    w1.x = pk2(s[8], s[9]); w1.y = pk2(s[10], s[11]); w1.z = pk2(s[12], s[13]); w1.w = pk2(s[14], s[15]);
    const bf16x8 pb0 = __builtin_bit_cast(bf16x8, w0), pb1 = __builtin_bit_cast(bf16x8, w1);
#pragma unroll
    for (int db = NEARLY; db < NDB; ++db) { vf[db][0] = *(const LAS bf16x8*)(vb + db * 32 * VP); vf[db][1] = *(const LAS bf16x8*)(vb + db * 32 * VP + 32); }
#pragma unroll
    for (int db = 0; db < NDB; ++db) { o[db] = mfma32(vf[db][0], pb0, o[db]); o[db] = mfma32(vf[db][1], pb1, o[db]); }
}
template <int NDB, int VP, bool WIN>
__device__ __forceinline__ void attn_tile(f32x16 (&o)[NDB], f32x16& negm, float& mref, float& lsum, int& first, const bf16x8 (&qf)[4],
                                          const LAS unsigned char* kb, const LAS unsigned char* vb, int mode  , int ql, int hh) {
    f32x16 s = attn_qk<WIN>(negm, qf, kb, mode, ql, hh), dummy = zero16();
    attn_pv<NDB, VP>(o, negm, mref, lsum, first, s, dummy, vb);
}
constexpr int DKP = 272, DVP = 144, DST_K = 64 * DKP, DST = DST_K + 128 * DVP;
__device__ __forceinline__ void diff_task(const Args& a, int layer, int b, int hc, int qg, LAS unsigned char* lds, int tid, int wave, int lane) {
    const int sub = wave >> 2, qt = qg * 4 + (wave & 3), ql = lane & 31, hh = lane >> 5;
    bf16_t* Q = (bf16_t*)(a.ws + WS_CQ); const bf16_t* SCG = (const bf16_t*)(a.ws + WS_SCG);
    const size_t qrow = (size_t)b * TOK + qt * 32 + ql;
    bf16x8 qf[4];
#pragma unroll
    for (int d0 = 0; d0 < 4; ++d0) qf[d0] = *(const bf16x8*)(Q + qrow * 512 + hc * 128 + sub * 64 + d0 * 16 + hh * 8);
    const int nst = qg < 2 ? 4 : 36;
    const unsigned char* gK = (const unsigned char*)(a.ws + WS_CK) + (((size_t)b * TOK + (tid >> 4)) * 512 + hc * 128) * 2 + (tid & 15) * 16;
    const unsigned char* gV = (const unsigned char*)(a.ws + WS_CVT) + (((size_t)b * 512 + hc * 128 + (tid >> 3)) * TOK) * 2 + (tid & 7) * 16;
    const int lK = (tid >> 4) * DKP + (tid & 15) * 16, lV = DST_K + (tid >> 3) * DVP + (tid & 7) * 16;
    u32x4 gk0, gk1, gv0, gv1;
#define DIFF_LOAD(st) do { gk0 = *(const u32x4*)(gK + (size_t)(st) * 64 * 1024); gk1 = *(const u32x4*)(gK + (size_t)(st) * 64 * 1024 + 32 * 1024); \
                           gv0 = *(const u32x4*)(gV + (size_t)(st) * 128); gv1 = *(const u32x4*)(gV + (size_t)(st) * 128 + (size_t)64 * TOK * 2); } while (0)
#define DIFF_WRITE(buf) do { LAS unsigned char* d_ = lds + (buf) * DST; *(LAS u32x4*)(d_ + lK) = gk0; *(LAS u32x4*)(d_ + lK + 32 * DKP) = gk1; \
                             *(LAS u32x4*)(d_ + lV) = gv0; *(LAS u32x4*)(d_ + lV + 64 * DVP) = gv1; } while (0)
    DIFF_LOAD(0); DIFF_WRITE(0);
    __syncthreads();
    const int kperm = (ql & ~12) | ((ql & 4) << 1) | ((ql & 8) >> 1);
    const int koff = kperm * DKP + (sub * 64 + hh * 8) * 2, voff = DST_K + ql * DVP + hh * 16;
    float mref = 0.f, lsum = 0.f; int first = 1;
    f32x16 negm = zero16();
    f32x16 o[4]; o[0] = zero16(); o[1] = zero16(); o[2] = zero16(); o[3] = zero16();
#pragma unroll 1
    for (int st = 0; st < nst; ++st) {
        if (st + 1 < nst) DIFF_LOAD(st + 1);
        const LAS unsigned char* cur = lds + (st & 1) * DST;
        { f32x16 s0 = attn_qk<false>(negm, qf, cur + koff, 0, ql, hh), s1 = attn_qk<false>(negm, qf, cur + koff + 32 * DKP, 0, ql, hh), dummy = zero16();
          attn_pv<4, DVP>(o, negm, mref, lsum, first, s0, s1, cur + voff);
          attn_pv<4, DVP>(o, negm, mref, lsum, first, s1, dummy, cur + voff + 64); }
        if (st + 1 < nst) DIFF_WRITE((st + 1) & 1);
        __syncthreads();
    }
#undef DIFF_LOAD
#undef DIFF_WRITE
    const float l = lsum + __shfl_xor(lsum, 32);
    const float lam = ((const float*)(a.ws + WS_TAB + T_LAM))[layer], lam_init = 0.8f - 0.6f * expf(-0.3f * (float)layer);
    LAS float* X = (LAS float*)lds + (wave & 3) * 4096;
    if (sub == 1) { const float sc = lam / l;
#pragma unroll
        for (int db = 0; db < 4; ++db)
#pragma unroll
            for (int r = 0; r < 16; ++r) { const int e = db * 32 + (r & 3) + 8 * (r >> 2) + 4 * hh; X[e * 32 + ql] = o[db][r] * sc; } }
    __syncthreads();
    if (sub == 0) { const float inv = 1.f / l; float ss = 0.f;
#pragma unroll
        for (int db = 0; db < 4; ++db)
#pragma unroll
            for (int r = 0; r < 16; ++r) { const int e = db * 32 + (r & 3) + 8 * (r >> 2) + 4 * hh; const float v = o[db][r] * inv - X[e * 32 + ql]; o[db][r] = v; ss += v * v; }
        ss += __shfl_xor(ss, 32);
        const float rs = (1.f - lam_init) / sqrtf(ss * (1.f / 128.f) + 1e-6f);
        const float* sw = a.in[I_SUBLN] + layer * 128;
#pragma unroll
        for (int db = 0; db < 4; ++db)
#pragma unroll
            for (int rg = 0; rg < 4; ++rg) { const int e = db * 32 + 8 * rg + 4 * hh; const size_t off = qrow * 512 + hc * 128 + e; const u32x2 g = *(const u32x2*)(SCG + off); const f32x4 w4 = *(const f32x4*)(sw + e);
                u32x2 w; w.x = pk2(o[db][4 * rg] * rs * w4[0] * bflo(g.x), o[db][4 * rg + 1] * rs * w4[1] * bfhi(g.x)); w.y = pk2(o[db][4 * rg + 2] * rs * w4[2] * bflo(g.y), o[db][4 * rg + 3] * rs * w4[3] * bfhi(g.y));
                *(u32x2*)(Q + off) = w; } }
    __syncthreads();
}

constexpr int SKP = 144, SST_K = 64 * SKP, SST = 2 * SST_K;
__device__ __forceinline__ void swa_task(const Args& a, int layer, int b, int kvh, int qp, LAS unsigned char* lds, int tid, int wave, int lane) {
    const int h = kvh * 4 + (wave & 3), qt0 = qp * 2, qt = qt0 + (wave >> 2), ql = lane & 31, hh = lane >> 5;
    bf16_t* Q = (bf16_t*)(a.ws + WS_AQ); const bf16_t* SAG = (const bf16_t*)(a.ws + WS_SAG);
    const size_t qrow = (size_t)b * TOK + qt * 32 + ql;
    bf16x8 qf[4];
#pragma unroll
    for (int d0 = 0; d0 < 4; ++d0) qf[d0] = *(const bf16x8*)(Q + qrow * 512 + h * 64 + d0 * 16 + hh * 8);
    int lo = 8, nlat = 0; if (qt0 >= 8) { lo = qt0 - 4 < 8 ? 8 : qt0 - 4; const int hi = qt0 + 5 > 71 ? 71 : qt0 + 5; nlat = (hi - lo + 1) >> 1; }
    const int nst = 4 + nlat;
    const unsigned char* gK = (const unsigned char*)(a.ws + WS_AK) + (((size_t)b * TOK + (tid >> 3)) * 128 + kvh * 64) * 2 + (tid & 7) * 16;
    const unsigned char* gV = (const unsigned char*)(a.ws + WS_AVT) + (((size_t)b * 128 + kvh * 64 + (tid >> 3)) * TOK) * 2 + (tid & 7) * 16;
    const int lK = (tid >> 3) * SKP + (tid & 7) * 16;
    u32x4 gk, gv;
#define SWA_KEY0(st) ((st) < 4 ? 64 * (st) : 32 * lo + 64 * ((st) - 4))
#define SWA_LOAD(st) do { const int k0_ = SWA_KEY0(st); gk = *(const u32x4*)(gK + (size_t)k0_ * 256); gv = *(const u32x4*)(gV + (size_t)k0_ * 2); } while (0)
#define SWA_WRITE(buf) do { LAS unsigned char* d_ = lds + (buf) * SST; *(LAS u32x4*)(d_ + lK) = gk; *(LAS u32x4*)(d_ + SST_K + lK) = gv; } while (0)
    SWA_LOAD(0); SWA_WRITE(0);
    __syncthreads();
    const int kperm = (ql & ~12) | ((ql & 4) << 1) | ((ql & 8) >> 1);
    const int koff = kperm * SKP + hh * 16, voff = SST_K + ql * SKP + hh * 16;
    float mref = a.in[I_SINK][layer * 8 + h] * LOG2E, lsum = hh == 0 ? 1.f : 0.f; int first = 0;
    f32x16 negm;
#pragma unroll
    for (int r = 0; r < 16; ++r) negm[r] = -mref;
    f32x16 o[2]; o[0] = zero16(); o[1] = zero16();
#pragma unroll 1
    for (int st = 0; st < nst; ++st) {
        if (st + 1 < nst) SWA_LOAD(st + 1);
        const LAS unsigned char* cur = lds + (st & 1) * SST;
        const int kt0 = SWA_KEY0(st) >> 5;
#pragma unroll
        for (int j = 0; j < 2; ++j) {
            const int kt = kt0 + j; int mode = 0; bool need = true;
            if (st >= 4) { need = (kt >= qt - 4) && (kt <= qt + 4); mode = kt == qt - 4 ? 1 : (kt == qt + 4 ? 2 : 0); }
            if (need) attn_tile<2, SKP, true>(o, negm, mref, lsum, first, qf, cur + koff + j * 32 * SKP, cur + voff + j * 64, mode, ql, hh);
        }
        if (st + 1 < nst) SWA_WRITE((st + 1) & 1);
        __syncthreads();
    }
#undef SWA_KEY0
#undef SWA_LOAD
#undef SWA_WRITE
    const float inv = 1.f / (lsum + __shfl_xor(lsum, 32));
#pragma unroll
    for (int db = 0; db < 2; ++db)
#pragma unroll
        for (int rg = 0; rg < 4; ++rg) { const size_t off = qrow * 512 + h * 64 + db * 32 + 8 * rg + 4 * hh; const u32x2 g = *(const u32x2*)(SAG + off);
            u32x2 w; w.x = pk2(o[db][4 * rg] * inv * bflo(g.x), o[db][4 * rg + 1] * inv * bfhi(g.x)); w.y = pk2(o[db][4 * rg + 2] * inv * bflo(g.y), o[db][4 * rg + 3] * inv * bfhi(g.y));
            *(u32x2*)(Q + off) = w; }
}

struct Cx { float r, i; };
__device__ __forceinline__ Cx cmuladd(Cx a, Cx s, float br, float bi) { Cx o; o.r = a.r * s.r - a.i * s.i + br; o.i = a.r * s.i + a.i * s.r + bi; return o; }
__device__ __forceinline__ const bf16_t* s5_uptr(const bf16_t* U, int b, int g, int dir, int J, int lane) {
    const int mrow = lane & 31, kh = lane >> 5, t = 16 * ((mrow >> 2) & 1) + (mrow & 3) + 4 * (mrow >> 3), tau = dir == 0 ? 32 * J + t : 32 * J + 31 - t;
    return U + ((size_t)b * TOK + tau) * 512 + g * 16 + kh * 8;
}
__device__ __forceinline__ void s5_chain_wave(const Args& a, int layer, int cw  , int lane) {
    const int combo = cw & 63, g = combo >> 1, dir = combo & 1, b = cw >> 6, ql = lane & 31, hh = lane >> 5;
    const int ld = layer * 2 + dir;
    const bf16_t* BbT = (const bf16_t*)(a.ws + WS_TAB + T_BBT) + (size_t)(ld * 32 + g) * 2048;
    const float* Ap = (const float*)(a.ws + WS_TAB + T_AP) + (size_t)(ld * 32 + g) * 384;
    const bf16_t* U = (const bf16_t*)(a.ws + WS_BU);
    bf16x8 bb[2][2]; Cx a1[2], a16[2], a32[2], hst[2];
#pragma unroll
    for (int ri = 0; ri < 2; ++ri)
#pragma unroll
        for (int pb = 0; pb < 2; ++pb) bb[ri][pb] = *(const bf16x8*)(BbT + ((ri * 64 + pb * 32 + ql) * 16 + hh * 8));
#pragma unroll
    for (int pb = 0; pb < 2; ++pb) { const int p = pb * 32 + ql; a1[pb].r = Ap[0 * 64 + p]; a1[pb].i = Ap[1 * 64 + p]; a16[pb].r = Ap[2 * 64 + p]; a16[pb].i = Ap[3 * 64 + p];
        a32[pb].r = Ap[4 * 64 + p]; a32[pb].i = Ap[5 * 64 + p]; hst[pb].r = 0.f; hst[pb].i = 0.f; }
    float* SC = (float*)(a.ws + WS_SC) + (((size_t)b * 32 + g) * 2 + dir) * 72 * 128;
    float* E0 = (float*)(a.ws + WS_E0) + (((size_t)b * 32 + g) * 2 + dir) * 72 * 128;
    bf16x8 un = *(const bf16x8*)s5_uptr(U, b, g, dir, dir == 0 ? 0 : 7, lane);
#pragma unroll 1
    for (int c = 0; c < 72; ++c) {
        const bf16x8 av = un;
        if (c + 1 < 72) { const int cn = c + 1; un = *(const bf16x8*)s5_uptr(U, b, g, dir, dir == 0 ? cn : (cn < 8 ? 7 - cn : 79 - cn), lane); }
#pragma unroll
        for (int pb = 0; pb < 2; ++pb) {
            const f32x16 br = mfma32(av, bb[0][pb], zero16()), bi = mfma32(av, bb[1][pb], zero16());
            Cx e = {0.f, 0.f};
#pragma unroll
            for (int r = 0; r < 16; ++r) e = cmuladd(a1[pb], e, br[r], bi[r]);
            Cx e0; e0.r = __shfl(e.r, ql); e0.i = __shfl(e.i, ql);
            const Cx sv = cmuladd(a16[pb], e0, e.r, e.i);
            Cx sl; sl.r = __shfl(sv.r, 32 + ql); sl.i = __shfl(sv.i, 32 + ql);
            if (hh == 1) { SC[c * 128 + pb * 32 + ql] = hst[pb].r; SC[c * 128 + 64 + pb * 32 + ql] = hst[pb].i; }
            else { E0[c * 128 + pb * 32 + ql] = e.r; E0[c * 128 + 64 + pb * 32 + ql] = e.i; }
            hst[pb] = cmuladd(a32[pb], hst[pb], sl.r, sl.i);
        }
    }
}
__device__ __forceinline__ void s5_pass3_wave(const Args& a, int layer, int gw, int ngw, LAS unsigned char* lds, int wave, int lane) {
    const int g = gw & 31, wi = gw >> 5, nwi = ngw >> 5, ql = lane & 31, hh = lane >> 5;
    if (wi >= nwi) return;
    LAS bf16_t* Hs = (LAS bf16_t*)(lds + wave * 8704);
    LAS bf16_t* Cl = (LAS bf16_t*)(lds + 69632 + wave * 8704);
    const bf16_t* U = (const bf16_t*)(a.ws + WS_BU);
    Cx a1[2][2], a16[2][2]; bf16x8 bb[2][2][2];
#pragma unroll
    for (int dir = 0; dir < 2; ++dir) {
        const int ld = layer * 2 + dir;
        const float* Ap = (const float*)(a.ws + WS_TAB + T_AP) + (size_t)(ld * 32 + g) * 384;
        const bf16_t* BbT = (const bf16_t*)(a.ws + WS_TAB + T_BBT) + (size_t)(ld * 32 + g) * 2048 + ql * 16 + hh * 8;
        const bf16_t* Cc = (const bf16_t*)(a.ws + WS_TAB + T_CC) + (size_t)(ld * 32 + g) * 2048;
#pragma unroll
        for (int pb = 0; pb < 2; ++pb) { const int p = pb * 32 + ql; a1[dir][pb].r = Ap[0 * 64 + p]; a1[dir][pb].i = Ap[1 * 64 + p]; a16[dir][pb].r = Ap[2 * 64 + p]; a16[dir][pb].i = Ap[3 * 64 + p];
            bb[dir][0][pb] = *(const bf16x8*)(BbT + pb * 512); bb[dir][1][pb] = *(const bf16x8*)(BbT + 1024 + pb * 512); }
#pragma unroll
        for (int q = 0; q < 4; ++q) { const int ch = lane + 64 * q, hrow = ch >> 4, c8 = ch & 15;
            *(LAS bf16x8*)(Cl + dir * 2176 + hrow * 136 + c8 * 8) = *(const bf16x8*)(Cc + hrow * 128 + c8 * 8); }
    }
    const int col = g * 16 + (lane & 15); const float dsk = a.in[I_SD][layer * 512 + col];
    bf16_t* YBF = (bf16_t*)(a.ws + WS_YBF);
    int it = wi;
    bf16x8 un0 = *(const bf16x8*)s5_uptr(U, it / 72, g, 0, it % 72, lane), un1 = *(const bf16x8*)s5_uptr(U, it / 72, g, 1, it % 72, lane);
#pragma unroll 1
    for (; it < 576; it += nwi) {
        const bf16x8 ua[2] = {un0, un1}; const int b = it / 72, J = it % 72;
        const int itn = it + nwi;
        const size_t row0 = (size_t)b * TOK + 32 * J + 4 * (lane >> 4);
        Cx hin[2][2], e0[2][2];
#pragma unroll
        for (int dir = 0; dir < 2; ++dir) {
            const int c = dir == 0 ? J : (J < 8 ? 7 - J : 79 - J);
            const size_t so = ((((size_t)b * 32 + g) * 2 + dir) * 72 + c) * 128;
            const float* SC = (const float*)(a.ws + WS_SC) + so; const float* E0 = (const float*)(a.ws + WS_E0) + so;
#pragma unroll
            for (int pb = 0; pb < 2; ++pb) { hin[dir][pb].r = SC[pb * 32 + ql]; hin[dir][pb].i = SC[64 + pb * 32 + ql]; e0[dir][pb].r = E0[pb * 32 + ql]; e0[dir][pb].i = E0[64 + pb * 32 + ql]; }
        }
        unsigned short ue[2][4];
#pragma unroll
        for (int rb = 0; rb < 2; ++rb)
#pragma unroll
            for (int i = 0; i < 4; ++i) ue[rb][i] = U[(row0 + 16 * rb + i) * 512 + col];
        if (itn < 576) { un0 = *(const bf16x8*)s5_uptr(U, itn / 72, g, 0, itn % 72, lane); un1 = *(const bf16x8*)s5_uptr(U, itn / 72, g, 1, itn % 72, lane); }
        f32x4 acc[2]; acc[0] = (f32x4){0.f, 0.f, 0.f, 0.f}; acc[1] = acc[0];
#pragma unroll
        for (int dir = 0; dir < 2; ++dir) {
#pragma unroll
            for (int pb = 0; pb < 2; ++pb) {
                const f32x16 bur = mfma32(ua[dir], bb[dir][0][pb], zero16()), bui = mfma32(ua[dir], bb[dir][1][pb], zero16());
                const Cx mid = cmuladd(a16[dir][pb], hin[dir][pb], e0[dir][pb].r, e0[dir][pb].i);
                Cx st = hh == 0 ? hin[dir][pb] : mid;
                LAS bf16_t* hp = Hs + (dir == 0 ? 16 * hh : 31 - 16 * hh) * 136 + 4 * ql + 2 * pb; const int hstep = dir == 0 ? 136 : -136;
#pragma unroll
                for (int r = 0; r < 16; ++r) { st = cmuladd(a1[dir][pb], st, bur[r], bui[r]); *(LAS unsigned*)hp = pk2(st.r, st.i); hp += hstep; }
            }
            asm volatile("" ::: "memory");
#pragma unroll
            for (int rb = 0; rb < 2; ++rb)
#pragma unroll
                for (int ks = 0; ks < 4; ++ks) { const bf16x8 af = *(const LAS bf16x8*)(Hs + (rb * 16 + (lane & 15)) * 136 + 32 * ks + 8 * (lane >> 4));
                    const bf16x8 cf = *(const LAS bf16x8*)(Cl + dir * 2176 + (lane & 15) * 136 + 32 * ks + 8 * (lane >> 4)); acc[rb] = mfma16(af, cf, acc[rb]); }
            asm volatile("" ::: "memory");
        }
#pragma unroll
        for (int rb = 0; rb < 2; ++rb)
#pragma unroll
            for (int i = 0; i < 4; ++i) YBF[(row0 + 16 * rb + i) * 512 + col] = f2bf(gelu_tanh(acc[rb][i] + dsk * bf2f(ue[rb][i])));
    }
}

#define XB_TMO      128
#define XB_XCNT(j)  (256  + 64 * (j))
#define XB_XSUB(j)  (1280 + 64 * (j))
#define XB_XGEN(j)  (2304 + 64 * (j))
#define XB_TOP      3328
#define XB_TOPGEN   3392
#define XCD_BAR_WORDS 3456
#define XB_SPIN_CAP (1u << 18)

__device__ __forceinline__ unsigned xb_ld(unsigned* p)              { return __hip_atomic_load(p, __ATOMIC_RELAXED, __HIP_MEMORY_SCOPE_AGENT); }
__device__ __forceinline__ unsigned xb_add(unsigned* p, unsigned v) { return __hip_atomic_fetch_add(p, v, __ATOMIC_RELAXED, __HIP_MEMORY_SCOPE_AGENT); }
__device__ __forceinline__ unsigned xb_xcc_id() { return (unsigned)__builtin_amdgcn_s_getreg((3 << 11) | 20) & 0xFu; }
#define XB_SPIN(cond, bar) do { unsigned _sp = 0; while (cond) { __builtin_amdgcn_s_sleep(1); \
    if ((++_sp & 255u) == 0u) { if (xb_ld(&(bar)[XB_TMO])) break; if (_sp > XB_SPIN_CAP) { atomicAdd(&(bar)[XB_TMO], 1u); break; } } } } while (0)

struct XcdBarrier {
    unsigned* bar; unsigned x;
    volatile LAS unsigned* st;
};

__device__ __forceinline__ XcdBarrier xcd_barrier_post(unsigned* bar, volatile LAS unsigned* st) {
    XcdBarrier b; b.bar = bar; b.x = xb_xcc_id(); b.st = st;
    if (threadIdx.x == 0) (void)xb_add(&bar[XB_XCNT(b.x)], 1u);
    return b;
}
__device__ __forceinline__ void xcd_barrier_complete(unsigned* bar, unsigned x, unsigned& nloc, unsigned& nx) {
    const unsigned G = gridDim.x * gridDim.y * gridDim.z;
    unsigned sum, cnt, mine, sp = 0u;
    for (;;) {
        sum = 0u; cnt = 0u; mine = 0u;
#pragma unroll
        for (unsigned j = 0; j < 16; ++j) { const unsigned c = xb_ld(&bar[XB_XCNT(j)]); sum += c; cnt += (c > 0u) ? 1u : 0u; mine = (j == x) ? c : mine; }
        if (sum == G) break;
        __builtin_amdgcn_s_sleep(1);
        if ((++sp & 255u) == 0u) { if (xb_ld(&bar[XB_TMO])) break; if (sp > XB_SPIN_CAP) { atomicAdd(&bar[XB_TMO], 1u); break; } }
    }
    nloc = mine > 0u ? mine : 1u; nx = cnt > 0u ? cnt : 1u;
}

__device__ __forceinline__ void xcd_barrier(const XcdBarrier& b) {
    asm volatile("s_waitcnt vmcnt(0)" ::: "memory");
    __syncthreads();
    if (threadIdx.x == 0) {
        unsigned* bar = b.bar;
        __builtin_amdgcn_s_waitcnt(0);
        unsigned nloc = b.st[0], nx = b.st[1];
        if (nloc == 0u) { xcd_barrier_complete(bar, b.x, nloc, nx); b.st[0] = nloc; b.st[1] = nx; }
        const unsigned old = xb_add(&bar[XB_XSUB(b.x)], 1u);
        const unsigned gen = old / nloc;
        if (old + 1u == (gen + 1u) * nloc) {
            __builtin_amdgcn_fence(__ATOMIC_RELEASE, "agent");
            asm volatile("s_waitcnt vmcnt(0)" ::: "memory");
            const unsigned og = xb_add(&bar[XB_TOP], 1u);
            const unsigned tg = og / nx;
            if (og + 1u == (tg + 1u) * nx) xb_add(&bar[XB_TOPGEN], 1u);
            else XB_SPIN(xb_ld(&bar[XB_TOPGEN]) == tg, bar);
            __builtin_amdgcn_fence(__ATOMIC_ACQUIRE, "agent");
            xb_add(&bar[XB_XGEN(b.x)], 1u);
            asm volatile("s_waitcnt vmcnt(0)" ::: "memory");
        } else {
            XB_SPIN(xb_ld(&bar[XB_XGEN(b.x)]) == gen, bar);
            __builtin_amdgcn_fence(__ATOMIC_ACQUIRE, "agent");
            asm volatile("s_waitcnt vmcnt(0)" ::: "memory");
        }
    }
    __syncthreads();
}

constexpr int NPHASE = 18;
#ifdef MK_ONLY
#define PH_ON(x) (((MK_ONLY) >> (x)) & 1)
#else
#define PH_ON(x) true
#endif
#ifndef MK_LAYER_UNROLL
#define MK_LAYER_UNROLL 1
#endif
__global__ void __launch_bounds__(512, 2) mk_fwd(Args a) {
    extern __shared__ __attribute__((aligned(16))) unsigned char lds_raw[];
    LAS unsigned char* lds = (LAS unsigned char*)lds_raw;
    cg::grid_group grid = cg::this_grid();
    volatile LAS unsigned* MISC = (volatile LAS unsigned*)(lds + LDS_MISC);
    if (threadIdx.x < 32) MISC[threadIdx.x] = 0u;
    __syncthreads();
    const XcdBarrier xbar = xcd_barrier_post((unsigned*)(a.ws + WS_BAR), MISC + 8);
    const int lo = a.ph_lo, hi = a.ph_hi;
    if (lo < 0) grid.sync();
#define PB() int tid = threadIdx.x; asm volatile("" : "+v"(tid)); const int lane = tid & 63, wave = __builtin_amdgcn_readfirstlane(tid >> 6); Args al = a; { size_t z_ = 0; asm volatile("" : "+s"(z_)); al.ws = a.ws + z_; } int G = gridDim.x, bx = blockIdx.x; asm volatile("" : "+s"(G), "+s"(bx)); (void)lane; (void)wave; (void)G; (void)bx
#define IN(k) (lo <= (k) && (k) < hi)
#define SEAM(k) do { if (IN(k) && IN((k) + 1)) xcd_barrier(xbar); } while (0)
    if (IN(0) && PH_ON(0)) { PB(); phase_p0(al, lds, tid, wave, lane); }
    SEAM(0);
    if (IN(1) && PH_ON(1)) { PB(); phase_hn0(al, wave, lane); }
    SEAM(1);
#pragma unroll MK_LAYER_UNROLL
    for (int layer = 0; layer < 2; ++layer) {
        const int pb = 2 + 8 * layer;
        if (IN(pb + 0) && PH_ON(2)) { PB();
            pg8::Gemm g{(const bf16_t*)(al.ws + WS_HN), ((bf16_t*)(al.ws + WS_W)) + W_IN, NROW, 4352, 1024}; pg8::StaticOrder S; S.init(NROW, 4352, G, bx);
            EpiIn E{al.ws, (const float2*)(al.ws + WS_TAB + T_ROPE)};
            pg8::gemm_phase<EpiIn, pg8::StaticOrder, false, true>(lds, g, S, E);
        }
        SEAM(pb + 0);
        if (IN(pb + 1) && PH_ON(3)) {
            { PB(); unsigned* fw = (unsigned*)(al.ws + WS_BAR) + 3712 + 64 * layer;
              const int nchain = G < 64 ? G : 64;
              if (bx < nchain) {
                for (int cw = bx * 8 + wave; cw < 512; cw += nchain * 8) s5_chain_wave(al, layer, cw, lane);
                asm volatile("s_waitcnt vmcnt(0)" ::: "memory"); __syncthreads();
                if (tid == 0) { __builtin_amdgcn_fence(__ATOMIC_RELEASE, "agent"); asm volatile("s_waitcnt vmcnt(0)" ::: "memory"); __hip_atomic_fetch_add(fw, 1u, __ATOMIC_RELAXED, __HIP_MEMORY_SCOPE_AGENT); }
              } }
            const int ntask = layer == 0 ? 1152 : 1024;
            for (;;) { PB();
                unsigned* qw = (unsigned*)(al.ws + WS_BAR) + 3584 + 64 * layer;
                volatile LAS unsigned* qs = (volatile LAS unsigned*)(lds + LDS_MISC) + 16;
                __syncthreads();
                if (tid == 0) qs[0] = __hip_atomic_fetch_add(qw, 1u, __ATOMIC_RELAXED, __HIP_MEMORY_SCOPE_AGENT);
                __syncthreads();
                const int t = (int)qs[0];
                if (t >= ntask) break;
                int tb, th, tq; bool isdiff;
                if (t < 512) { isdiff = true; tb = t >> 6; th = (t >> 4) & 3; tq = 2 + (t & 15); }
                else if (t < 1024) { const int u = t - 512; isdiff = false; tb = u >> 6; th = (u >> 5) & 1; tq = 4 + (u & 31); }
                else if (t < 1088) { const int u = t - 1024; isdiff = true; tb = u >> 3; th = (u >> 1) & 3; tq = u & 1; }
                else { const int u = t - 1088; isdiff = false; tb = u >> 3; th = (u >> 2) & 1; tq = u & 3; }
                if (isdiff) diff_task(al, layer, tb, th, tq, lds, tid, wave, lane); else swa_task(al, layer, tb, th, tq, lds, tid, wave, lane);
            }
            { PB(); unsigned* fw = (unsigned*)(al.ws + WS_BAR) + 3712 + 64 * layer; const int nchain = G < 64 ? G : 64;
              __syncthreads();
              if (tid == 0) { unsigned sp = 0; while (__hip_atomic_load(fw, __ATOMIC_RELAXED, __HIP_MEMORY_SCOPE_AGENT) < (unsigned)nchain) { __builtin_amdgcn_s_sleep(2); if (++sp > (1u << 22)) break; }
                              __builtin_amdgcn_fence(__ATOMIC_ACQUIRE, "agent"); asm volatile("s_waitcnt vmcnt(0)" ::: "memory"); }
              __syncthreads();
              s5_pass3_wave(al, layer, bx * 8 + wave, G * 8, lds, wave, lane); }
        }
        SEAM(pb + 3);
        if (IN(pb + 4) && PH_ON(6)) {
            { PB(); pg8::Gemm g{(const bf16_t*)(al.ws + WS_YBF), ((bf16_t*)(al.ws + WS_W)) + W_GLU, NROW, 512, 512}; FlexOrder S; S.init(512, G, (layer == 0 && G == 256) ? ((bx + 144) & 255) : bx, layer == 1 ? 1 : 0);
              EpiRow<4> E{(bf16_t*)(al.ws + WS_SBG), 512, (const bf16_t*)(al.ws + WS_YBF), al.in[I_BGLU] + layer * 512, nullptr, 0, false, false, al.ws};
              pg8::gemm_phase<EpiRow<4>, FlexOrder, true, true>(lds, g, S, E); }
            if (layer == 0) { PB();
                pg8::Gemm g{(const bf16_t*)(al.ws + WS_HN), ((bf16_t*)(al.ws + WS_W)) + W_IN + (size_t)4352 * 1024, NROW, 3072, 1024}; FlexOrder S; S.init(3072, G, bx, 3);
                EpiRow<1> E{(bf16_t*)(al.ws + WS_MCTX), 3072, nullptr, nullptr, nullptr, 0, true, false, al.ws};
                pg8::gemm_phase<EpiRow<1>, FlexOrder, true, true>(lds, g, S, E);
            }
            { PB(); unsigned* fw = (unsigned*)(al.ws + WS_BAR) + 3840 + 64 * layer;
              unsigned* pc = (unsigned*)(al.ws + WS_BAR) + 3968 + 16 * layer + xbar.x;
              asm volatile("s_waitcnt vmcnt(0)" ::: "memory"); __syncthreads();
              if (tid == 0) { const unsigned nloc = xbar.st[0]; const unsigned old = __hip_atomic_fetch_add(pc, 1u, __ATOMIC_RELAXED, __HIP_MEMORY_SCOPE_AGENT);
                  if (old + 1u == nloc) { __builtin_amdgcn_fence(__ATOMIC_RELEASE, "agent"); asm volatile("s_waitcnt vmcnt(0)" ::: "memory"); __hip_atomic_fetch_add(fw, nloc, __ATOMIC_RELAXED, __HIP_MEMORY_SCOPE_AGENT); } } }
            if (layer == 1) {
                { PB(); FlexOrder S2; S2.init(1024, G, bx, 6); bf16_t* Wb = (bf16_t*)(al.ws + WS_W);
                  pg8::Gemm g{(const bf16_t*)(al.ws + WS_HN), Wb + W_IN + (size_t)4352 * 1024, NROW, 1024, 1024, (const bf16_t*)(al.ws + WS_HN), Wb + W_IN + (size_t)(4352 + 2048) * 1024, nullptr, nullptr};
                  EpiRow<1> E{nullptr, 1024, nullptr, nullptr, nullptr, 0, false, false, al.ws, false, true};
                  pg8::gemm_phase<EpiRow<1>, FlexOrder, true, true>(lds, g, S2, E); }
                { PB(); FlexOrder S2; S2.init(1024, G, bx, 6); bf16_t* Wb = (bf16_t*)(al.ws + WS_W);
                  pg8::Gemm g2{(const bf16_t*)(al.ws + WS_AQ), Wb + W_OA, NROW, 1024, 512, (const bf16_t*)(al.ws + WS_CQ), Wb + W_OC, nullptr, nullptr};
                  EpiRow<3> E{(bf16_t*)(al.ws + WS_YBUF), 1024, nullptr, nullptr, nullptr, 0, false, false, al.ws, false, true};
                  pg8::gemm_phase<EpiRow<3>, FlexOrder, true, true>(lds, g2, S2, E); }
            }
#pragma unroll
            for (int bo = (layer == 1 ? 2 : 0); bo < 3; ++bo) {
                const int br = bo == 0 ? 0 : (bo == 1 ? 2 : 1);
                if (bo == 2) { PB();
                    unsigned* fw = (unsigned*)(al.ws + WS_BAR) + 3840 + 64 * layer;
                    __syncthreads();
                    if (tid == 0) { unsigned sp = 0; while (__hip_atomic_load(fw, __ATOMIC_RELAXED, __HIP_MEMORY_SCOPE_AGENT) < (unsigned)G) { __builtin_amdgcn_s_sleep(2); if (++sp > (1u << 22)) break; }
                                    __builtin_amdgcn_fence(__ATOMIC_ACQUIRE, "agent"); asm volatile("s_waitcnt vmcnt(0)" ::: "memory"); }
                    __syncthreads();
                }
                { PB(); FlexOrder SL; SL.init(1024, G, bx, 1);
                  pg8::Gemm g{(const bf16_t*)(al.ws + WS_HN), ((bf16_t*)(al.ws + WS_W)) + W_IN + (size_t)(4352 + 1024 * br) * 1024, NROW, 1024, 1024}; EpiRow<1> E{nullptr, 1024, nullptr, nullptr, nullptr, 0, false, false, al.ws};
                  pg8::gemm_phase<EpiRow<1>, FlexOrder, true, true>(lds, g, SL, E); }
                { PB(); FlexOrder SO; SO.init(1024, G, bx, 1);
                  bf16_t* YB = (bf16_t*)(al.ws + WS_YBUF); const bf16_t* MC = layer == 0 ? (const bf16_t*)(al.ws + WS_MCTX) : nullptr;
                  pg8::Gemm g2{(const bf16_t*)(al.ws + (br == 0 ? WS_AQ : (br == 1 ? WS_SBG : WS_CQ))), ((bf16_t*)(al.ws + WS_W)) + (br == 0 ? W_OA : (br == 1 ? W_OB : W_OC)), NROW, 1024, 512};
                  if (bo == 0) { EpiRow<2> E{YB, 1024, nullptr, nullptr, MC, 1024 * br, false, false, al.ws}; pg8::gemm_phase<EpiRow<2>, FlexOrder, true, true>(lds, g2, SO, E); }
                  else { EpiRow<3> E{YB, 1024, nullptr, nullptr, MC, 1024 * br, false, false, al.ws}; pg8::gemm_phase<EpiRow<3>, FlexOrder, true, true>(lds, g2, SO, E); } }
            }
            if (layer == 0) { PB();
                FlexOrder S5; S5.init(1024, G, bx, 5);
                bf16_t* Wb = (bf16_t*)(al.ws + WS_W);
                pg8::Gemm g2{(const bf16_t*)(al.ws + WS_SBG), Wb + W_OB, NROW, 1024, 512, (const bf16_t*)(al.ws + WS_AQ), Wb + W_OA, (const bf16_t*)(al.ws + WS_CQ), Wb + W_OC};
                EpiRow<3> E{(bf16_t*)(al.ws + WS_YBUF), 1024, nullptr, nullptr, (const bf16_t*)(al.ws + WS_MCTX), 0, false, false, al.ws, true};
                pg8::gemm_phase<EpiRow<3>, FlexOrder, true, true>(lds, g2, S5, E);
            }
        }
        SEAM(pb + 5);
        if (IN(pb + 6) && PH_ON(8)) { PB();
            pg8::Gemm g{(const bf16_t*)(al.ws + WS_YBUF), ((bf16_t*)(al.ws + WS_W)) + W_OUT, NROW, 1024, 1024}; FlexOrder S; S.init(1024, G, bx, layer == 0 ? 2 : 1);
            EpiRow<0> E{(bf16_t*)(al.ws + WS_YO), 1024, nullptr, nullptr, nullptr, 0, false, false, al.ws};
            pg8::gemm_phase<EpiRow<0>, FlexOrder, true, true>(lds, g, S, E);
            if (layer == 0) { const int nb = G > 32 ? G - 32 : 0; if (bx >= 32) weights_layer(al, 1, lds, (bx - 32) * 8 + wave, nb * 8, wave, lane, 0); }
        }
        SEAM(pb + 6);
        if (IN(pb + 7) && PH_ON(9)) { PB(); phase_resid(al, layer, lds, wave, lane); }
        if (layer == 0) SEAM(pb + 7);
    }
#undef IN
#undef SEAM
#undef PB
}

extern "C" void kernel_launch(void* const* d_in, const int* in_sizes, int n_in, void* d_out, int out_size, void* d_ws, size_t ws_size, hipStream_t stream) {
    static int grid = 0;
    if (grid == 0) {
        if (n_in != 29 || ws_size < WS_END) { fprintf(stderr, "kernel_launch: unexpected n_in %d / ws %zu\n", n_in, ws_size); grid = -1; return; }
        int dev = 0, cus = 0, per_cu = 0;
        hipGetDevice(&dev); hipDeviceGetAttribute(&cus, hipDeviceAttributeMultiprocessorCount, dev);
        hipFuncSetAttribute((const void*)mk_fwd, hipFuncAttributeMaxDynamicSharedMemorySize, LDS_BYTES);
        hipOccupancyMaxActiveBlocksPerMultiprocessor(&per_cu, (const void*)mk_fwd, 512, LDS_BYTES);
        if (per_cu < 1) { fprintf(stderr, "kernel_launch: occupancy query reports %d blocks per CU\n", per_cu); per_cu = 1; }
        (void)hipGetLastError();
        grid = cus;
        fprintf(stderr, "kernel_launch: grid %d (cus %d, per_cu %d)\n", grid, cus, per_cu);
    }
    if (grid < 0) return;
    (void)hipMemsetAsync((char*)d_ws + WS_BAR, 0, 16384, stream);
    Args a{};
    for (int i = 0; i < 29; ++i) a.in[i] = (const float*)d_in[i];
    a.out = (float*)d_out; a.ws = (unsigned char*)d_ws;
#if MK_PER_PHASE
    for (int ph = 0; ph < NPHASE; ++ph) { a.ph_lo = ph; a.ph_hi = ph + 1; hipLaunchKernelGGL(mk_fwd, dim3(grid), dim3(512), LDS_BYTES, stream, a); }
#else
    a.ph_lo = 0; a.ph_hi = NPHASE;
    void* args[] = {&a};
    hipError_t e = hipLaunchCooperativeKernel((const void*)mk_fwd, dim3(grid), dim3(512), args, LDS_BYTES, stream);
    if (e != hipSuccess) fprintf(stderr, "kernel_launch: cooperative launch failed: %s (grid %d)\n", hipGetErrorString(e), grid);
#endif
}
```

```cpp
#include <hip/hip_runtime.h>
#include <hip/hip_cooperative_groups.h>
#include <cstdio>
#include <cstdint>
namespace cg = cooperative_groups;
#ifndef MK_PER_PHASE
#define MK_PER_PHASE 0
#endif
namespace pg8 {
#define PG8_LAS __attribute__((address_space(3)))
typedef unsigned short bf16_t;
typedef short bf16x8 __attribute__((ext_vector_type(8)));
typedef float f32x4 __attribute__((ext_vector_type(4)));
typedef unsigned u32x4 __attribute__((ext_vector_type(4)));
constexpr int BM = 256, BK = 64, HALF = 128, HTB = HALF * BK * 2  , STAGE_BYTES = 8 * HTB, NXCD = 8, WGM = 4;

__host__ __device__ __forceinline__ int lds_byte(int r, int c) { const int st = (r >> 4) * 2 + (c >> 5), rr = r & 15, cc = c & 31, ob = rr * 64 + cc * 2; return st * 1024 + (ob ^ (((ob >> 9) & 1) << 5)); }
__host__ __device__ __forceinline__ void stage_rc(int b, int& R, int& C) { const int st = b / 1024, sb = b % 1024, swz = sb ^ (((sb >> 9) & 1) << 5); R = (st >> 1) * 16 + swz / 64; C = (st & 1) * 32 + (swz % 64) / 2; }
__host__ __device__ __forceinline__ int perm32(int rho) { const int n = rho >> 4, i = rho & 15; return 8 * (i >> 2) + 4 * n + (i & 3); }

struct Unit { int pm, pn, kind; };
struct Gemm { const bf16_t* A; const bf16_t* Bt; int M, N, K; const bf16_t* A1; const bf16_t* Bt1; const bf16_t* A2; const bf16_t* Bt2; };

struct StaticOrder {
    int nM, nN, nwg, G, c;
    __host__ __device__ __forceinline__ void init(int M, int N, int G_, int c_) { nM = M / BM; nN = N / BM; nwg = nM * nN; G = G_; c = c_; }
    __host__ __device__ __forceinline__ bool next(int i, Unit& u) const {
        const long L = (long)i * G + c; if (L >= nwg) return false;
        int wgid = (int)L; { const int q = nwg / NXCD, r = nwg % NXCD, xcd = wgid % NXCD, off = wgid / NXCD; wgid = (xcd < r ? xcd * (q + 1) : r * (q + 1) + (xcd - r) * q) + off; }
        const int nig = WGM * nN, gid = wgid / nig, fm = gid * WGM, gsz = (nM - fm) < WGM ? (nM - fm) : WGM;
        u.pm = fm + ((wgid % nig) % gsz); u.pn = (wgid % nig) / gsz; u.kind = 0; return true;
    }
    __device__ __forceinline__ void a_ready(const Unit&) const {}
    __device__ __forceinline__ void done(const Unit&) const {}
};

__device__ __forceinline__ unsigned cvt_pk_bf16(float lo, float hi) { unsigned r; asm volatile("v_cvt_pk_bf16_f32 %0, %1, %2" : "=v"(r) : "v"(lo), "v"(hi)); return r; }
template <class Epi, class Sched, bool ALIGN_EPI = false, bool SP2 = false>
__device__ __forceinline__ void gemm_phase(PG8_LAS unsigned char* lds, const Gemm g, const Sched& S, const Epi& E) {
    int tid_ = threadIdx.x; asm volatile("" : "+v"(tid_)); const int tid = tid_, wid = __builtin_amdgcn_readfirstlane(tid >> 6), lane = tid & 63, wr = wid >> 2, wc = wid & 3, fr = lane & 15, fq = lane >> 4;
    const int K = g.K, nt = K / BK;
    unsigned voffA[2], voffB[2];
#pragma unroll
    for (int i = 0; i < 2; ++i) { int R, C; stage_rc(tid * 16 + i * 8192, R, C); const int Rb = Epi::PERM ? ((R & ~31) + perm32(R & 31)) : R;
        voffA[i] = (unsigned)(R * K + C) * 2u; voffB[i] = (unsigned)(Rb * K + C) * 2u; }
    const size_t kstep = (size_t)(BK * 2);
    const size_t hstep = (size_t)HALF * K * 2;
    const size_t tstep = 2 * hstep;
    const unsigned ldsw = (unsigned)wid * 1024u;
    const int aoff = lds_byte(wr * 64 + fr, fq * 8), boff = lds_byte(wc * 32 + fr, fq * 8);
#define PG8_SA(b, h) (((b) * 2 + (h)) * HTB)
#define PG8_SB(b, h) ((4 + (b) * 2 + (h)) * HTB)
#define PG8_STAGE(bufoff, gbase, voff) do { _Pragma("unroll") for (int _i = 0; _i < 2; ++_i) \
        __builtin_amdgcn_global_load_lds((const unsigned*)((const char*)(gbase) + (voff)[_i]), (PG8_LAS unsigned*)(lds + (bufoff) + ldsw + _i * 8192), 16, 0, 0); } while (0)
#define PG8_LDA(dst, b, h) do { _Pragma("unroll") for (int m = 0; m < 4; ++m) _Pragma("unroll") for (int k = 0; k < 2; ++k) dst[m][k] = *(const PG8_LAS bf16x8*)(lds + PG8_SA(b, h) + aoff + m * 2048 + k * 1024); } while (0)
#define PG8_LDB(dst, b, h) do { _Pragma("unroll") for (int n = 0; n < 2; ++n) _Pragma("unroll") for (int k = 0; k < 2; ++k) dst[n][k] = *(const PG8_LAS bf16x8*)(lds + PG8_SB(b, h) + boff + n * 2048 + k * 1024); } while (0)
#define PG8_MMA(ai, bj, At, Bt) do { __builtin_amdgcn_s_setprio(1); _Pragma("unroll") for (int m = 0; m < 4; ++m) _Pragma("unroll") for (int n = 0; n < 2; ++n) _Pragma("unroll") for (int k = 0; k < 2; ++k) \
        acc[ai][bj][m][n] = __builtin_amdgcn_mfma_f32_16x16x32_bf16(Bt[n][k], At[m][k], acc[ai][bj][m][n], 0, 0, 0); __builtin_amdgcn_s_setprio(0); } while (0)
#define PG8_WAIT_V(n) asm volatile("s_waitcnt vmcnt(" #n ")" ::: "memory")
#define PG8_WAIT_L(n) asm volatile("s_waitcnt lgkmcnt(" #n ")" ::: "memory")
#define PG8_BAR __builtin_amdgcn_s_barrier()
#define PG8_SCHED __builtin_amdgcn_sched_barrier(0)
    Unit cur, nxt; int ui = 0;
    if (!S.next(0, cur)) return;
    f32x4 acc[2][2][4][2];
#pragma unroll
    for (int a = 0; a < 2; ++a)
#pragma unroll
        for (int b = 0; b < 2; ++b)
#pragma unroll
            for (int m = 0; m < 4; ++m)
#pragma unroll
                for (int n = 0; n < 2; ++n) acc[a][b][m][n] = (f32x4){0.f, 0.f, 0.f, 0.f};
    bf16x8 At[4][2], B0[2][2], B1[2][2];
    const char* cA = (const char*)(cur.kind == 0 ? g.A : (cur.kind == 1 ? g.A1 : g.A2)) + (size_t)cur.pm * tstep; const char* cB = (const char*)(cur.kind == 0 ? g.Bt : (cur.kind == 1 ? g.Bt1 : g.Bt2)) + (size_t)cur.pn * tstep;
    S.a_ready(cur);
    if constexpr (SP2) {
        PG8_STAGE(PG8_SB(0, 0), cB, voffB); PG8_STAGE(PG8_SB(0, 1), cB + hstep, voffB); PG8_STAGE(PG8_SA(0, 0), cA, voffA); PG8_STAGE(PG8_SA(0, 1), cA + hstep, voffA);
        if (wr == 1) PG8_BAR;
        PG8_WAIT_V(2); PG8_BAR;
        PG8_STAGE(PG8_SB(1, 0), cB + kstep, voffB); PG8_STAGE(PG8_SA(1, 0), cA + kstep, voffA); PG8_STAGE(PG8_SB(1, 1), cB + hstep + kstep, voffB);
        PG8_WAIT_V(6); PG8_BAR;
    } else {
        PG8_STAGE(PG8_SB(0, 0), cB, voffB); PG8_STAGE(PG8_SA(0, 0), cA, voffA); PG8_STAGE(PG8_SB(0, 1), cB + hstep, voffB); PG8_STAGE(PG8_SA(0, 1), cA + hstep, voffA);
        if (wr == 1) PG8_BAR;
        PG8_WAIT_V(4); PG8_BAR;
        PG8_STAGE(PG8_SB(1, 0), cB + kstep, voffB); PG8_STAGE(PG8_SA(1, 0), cA + kstep, voffA); PG8_STAGE(PG8_SB(1, 1), cB + hstep + kstep, voffB);
        PG8_WAIT_V(6); PG8_BAR;
    }
    for (;;) {
        const bool has_next = S.next(ui + 1, nxt);
        const char* nA = has_next ? (const char*)(nxt.kind == 0 ? g.A : (nxt.kind == 1 ? g.A1 : g.A2)) + (size_t)nxt.pm * tstep : cA; const char* nB = has_next ? (const char*)(nxt.kind == 0 ? g.Bt : (nxt.kind == 1 ? g.Bt1 : g.Bt2)) + (size_t)nxt.pn * tstep : cB;
        for (int t = 0; t < nt; t += 2) {
            const bool last = (t == nt - 2);
            const char* a1 = cA + (size_t)(t + 1) * kstep;
            const char* a2 = last ? nA : cA + (size_t)(t + 2) * kstep; const char* b2 = last ? nB : cB + (size_t)(t + 2) * kstep;
            const char* a3 = a2 + kstep; const char* b3 = b2 + kstep;
            if (last && has_next) S.a_ready(nxt);
            if constexpr (SP2) {
            PG8_LDB(B0, 0, 0); PG8_LDB(B1, 0, 1); PG8_SCHED; PG8_LDA(At, 0, 0); PG8_STAGE(PG8_SA(1, 1), a1 + hstep, voffA);
            PG8_WAIT_V(8); PG8_WAIT_L(0); PG8_BAR; PG8_MMA(0, 0, At, B0); PG8_MMA(0, 1, At, B1); PG8_BAR; PG8_SCHED;
            PG8_LDA(At, 0, 1); PG8_STAGE(PG8_SB(0, 0), b2, voffB); PG8_STAGE(PG8_SB(0, 1), b2 + hstep, voffB); PG8_STAGE(PG8_SA(0, 0), a2, voffA);
            PG8_WAIT_V(8); PG8_WAIT_L(0); PG8_BAR; PG8_MMA(1, 0, At, B0); PG8_MMA(1, 1, At, B1); PG8_BAR; PG8_SCHED;
            PG8_LDB(B0, 1, 0); PG8_LDB(B1, 1, 1); PG8_SCHED; PG8_LDA(At, 1, 0); PG8_STAGE(PG8_SA(0, 1), a2 + hstep, voffA);
            PG8_WAIT_V(8); PG8_WAIT_L(0); PG8_BAR; PG8_MMA(0, 0, At, B0); PG8_MMA(0, 1, At, B1); PG8_BAR; PG8_SCHED;
            PG8_LDA(At, 1, 1); PG8_STAGE(PG8_SB(1, 0), b3, voffB); PG8_STAGE(PG8_SB(1, 1), b3 + hstep, voffB); PG8_STAGE(PG8_SA(1, 0), a3, voffA);
            PG8_WAIT_V(8); PG8_WAIT_L(0); PG8_BAR; PG8_MMA(1, 0, At, B0); PG8_MMA(1, 1, At, B1); PG8_BAR; PG8_SCHED;
            } else {
            PG8_LDB(B0, 0, 0); PG8_SCHED; PG8_LDA(At, 0, 0); PG8_STAGE(PG8_SA(1, 1), a1 + hstep, voffA);
            PG8_WAIT_L(8); PG8_BAR; PG8_WAIT_L(0); PG8_MMA(0, 0, At, B0); PG8_BAR; PG8_SCHED;
            PG8_LDB(B1, 0, 1); PG8_STAGE(PG8_SB(0, 0), b2, voffB);
            PG8_BAR; PG8_WAIT_L(0); PG8_MMA(0, 1, At, B1); PG8_BAR;
            PG8_LDA(At, 0, 1); PG8_STAGE(PG8_SA(0, 0), a2, voffA);
            PG8_BAR; PG8_WAIT_L(0); PG8_MMA(1, 0, At, B0); PG8_BAR; PG8_SCHED;
            PG8_STAGE(PG8_SB(0, 1), b2 + hstep, voffB);
            PG8_WAIT_V(6); PG8_BAR; PG8_MMA(1, 1, At, B1); PG8_BAR;
            PG8_LDB(B0, 1, 0); PG8_SCHED; PG8_LDA(At, 1, 0); PG8_STAGE(PG8_SA(0, 1), a2 + hstep, voffA);
            PG8_WAIT_L(8); PG8_BAR; PG8_WAIT_L(0); PG8_MMA(0, 0, At, B0); PG8_BAR; PG8_SCHED;
            PG8_LDB(B1, 1, 1); PG8_STAGE(PG8_SB(1, 0), b3, voffB);
            PG8_BAR; PG8_WAIT_L(0); PG8_MMA(0, 1, At, B1); PG8_BAR;
            PG8_LDA(At, 1, 1); PG8_STAGE(PG8_SA(1, 0), a3, voffA);
            PG8_BAR; PG8_WAIT_L(0); PG8_MMA(1, 0, At, B0); PG8_BAR; PG8_SCHED;
            PG8_STAGE(PG8_SB(1, 1), b3 + hstep, voffB);
            PG8_WAIT_V(6); PG8_BAR; PG8_MMA(1, 1, At, B1); PG8_BAR;
            }
        }
        if constexpr (ALIGN_EPI) { if (wr == 0) PG8_BAR; }
        if constexpr (!Epi::AFTER_DRAIN) { E(acc, cur, wr, wc, fr, fq); S.done(cur); }
        if (!has_next) break;
#pragma unroll
        for (int a = 0; a < 2; ++a)
#pragma unroll
            for (int b = 0; b < 2; ++b)
#pragma unroll
                for (int m = 0; m < 4; ++m)
#pragma unroll
                    for (int n = 0; n < 2; ++n) acc[a][b][m][n] = (f32x4){0.f, 0.f, 0.f, 0.f};
        cur = nxt; cA = nA; cB = nB; ++ui;
        if constexpr (ALIGN_EPI) { if (wr == 1) PG8_BAR; }
    }
    PG8_WAIT_V(0);
    if constexpr (!ALIGN_EPI) { if (wr == 0) PG8_BAR; }
    PG8_BAR;
    if constexpr (Epi::AFTER_DRAIN) { E.fused(acc, cur, wr, wc, fr, fq, lds, wid, lane); S.done(cur); }
#undef PG8_SA
#undef PG8_SB
#undef PG8_STAGE
#undef PG8_LDA
#undef PG8_LDB
#undef PG8_MMA
#undef PG8_WAIT_V
#undef PG8_WAIT_L
#undef PG8_BAR
#undef PG8_SCHED
}
}

#define LAS __attribute__((address_space(3)))
using pg8::Unit; using pg8::f32x4; using pg8::bf16x8; using pg8::bf16_t; using pg8::u32x4;
typedef float f32x16 __attribute__((ext_vector_type(16)));
typedef unsigned u32x2 __attribute__((ext_vector_type(2)));
typedef float f32x2_t __attribute__((ext_vector_type(2)));
typedef __bf16 bf16x2_t __attribute__((ext_vector_type(2)));

constexpr int NBATCH = 8, TOK = 2304, NROW = NBATCH * TOK, DM = 1024;
constexpr float LOG2E = 1.4426950408889634f, QS = 0.125f * 1.4426950408889634f;
constexpr size_t MiB = 1u << 20;
constexpr size_t WS_TAB = 0, WS_W = 2 * MiB, WS_HN = 22 * MiB, WS_AQ = 58 * MiB, WS_AK = 76 * MiB, WS_AVT = 80 * MiB + MiB / 2, WS_SAG = 85 * MiB, WS_SCG = 103 * MiB,
                 WS_BU = 121 * MiB, WS_SBG = 139 * MiB, WS_CQ = 157 * MiB, WS_CK = 175 * MiB, WS_CVT = 193 * MiB, WS_SC = 211 * MiB, WS_H1C = 229 * MiB, WS_MCTX = 237 * MiB  , WS_END = 255 * MiB;
constexpr size_t WS_E0 = 237 * MiB;
constexpr size_t WS_MB2 = 211 * MiB;
constexpr size_t WS_YBUF = WS_SAG  , WS_YO = WS_BU  , WS_MBUF = WS_CK  , WS_YBF = WS_BU  ;
constexpr size_t W_IN = 0, W_OA = (size_t)7424 * 1024, W_OB = W_OA + 1024 * 512, W_OC = W_OB + 1024 * 512, W_OUT = W_OC + 1024 * 512, W_GLU = W_OUT + 1024 * 1024;
constexpr size_t T_MOD = 0, T_ROPE = 221184, T_LAM = 229376, T_BBT = 229632, T_AP = 753920, T_CC = 950528;
constexpr int LDS_BYTES = 147456;
constexpr size_t WS_BAR = 1572864;
constexpr int LDS_MISC = 147456 - 512;

struct Args { const float* in[29]; float* out; unsigned char* ws; int ph_lo, ph_hi; };
enum { I_X = 0, I_C, I_CTX, I_CCTX, I_WMOD, I_BMOD, I_NPRE, I_NPOST, I_WIN, I_SINK, I_ARE, I_AIM, I_LOGDT, I_BRE, I_BIM, I_CRE, I_CIM, I_SD, I_WGLU, I_BGLU,
       I_LQ1, I_LK1, I_LQ2, I_LK2, I_SUBLN, I_WOA, I_WOB, I_WOC, I_WOUT };

__device__ __forceinline__ unsigned pk2(float lo, float hi) { f32x2_t v = {lo, hi}; bf16x2_t b = __builtin_convertvector(v, bf16x2_t); return __builtin_bit_cast(unsigned, b); }
__device__ __forceinline__ bf16_t f2bf(float f) { return (bf16_t)(pk2(f, 0.f) & 0xffffu); }
__device__ __forceinline__ float bf2f(unsigned short h) { return __builtin_bit_cast(float, (unsigned)h << 16); }
__device__ __forceinline__ float bflo(unsigned w) { return __builtin_bit_cast(float, w << 16); }
__device__ __forceinline__ float bfhi(unsigned w) { return __builtin_bit_cast(float, w & 0xffff0000u); }
__device__ __forceinline__ void store8(bf16_t* p, const float (&v)[8]) { u32x4 w; w.x = pk2(v[0], v[1]); w.y = pk2(v[2], v[3]); w.z = pk2(v[4], v[5]); w.w = pk2(v[6], v[7]); *(u32x4*)p = w; }
__device__ __forceinline__ void load8(const bf16_t* p, float (&v)[8]) { const u32x4 w = *(const u32x4*)p; v[0] = bflo(w.x); v[1] = bfhi(w.x); v[2] = bflo(w.y); v[3] = bfhi(w.y); v[4] = bflo(w.z); v[5] = bfhi(w.z); v[6] = bflo(w.w); v[7] = bfhi(w.w); }
#define LOG2E_ 1.4426950408889634f
__device__ __forceinline__ float sigmoidf_(float x) { return __builtin_amdgcn_rcpf(1.f + __builtin_amdgcn_exp2f(-LOG2E_ * x)); }
__device__ __forceinline__ float siluf_(float x) { return x * __builtin_amdgcn_rcpf(1.f + __builtin_amdgcn_exp2f(-LOG2E_ * x)); }
__device__ __forceinline__ float gelu_tanh(float x) { const float u = 0.7978845608028654f * (x + 0.044715f * x * x * x); const float t = 1.f - 2.f * __builtin_amdgcn_rcpf(1.f + __builtin_amdgcn_exp2f(2.f * LOG2E_ * u)); return 0.5f * x * (1.f + t); }
__device__ __forceinline__ float wave_sum(float v) {
#pragma unroll
    for (int o = 1; o < 64; o <<= 1) v += __shfl_xor(v, o);
    return v;
}
__device__ __forceinline__ float xhalf_max(float x) { auto rr = __builtin_amdgcn_permlane32_swap(__float_as_uint(x), __float_as_uint(x), false, false); return fmaxf(__uint_as_float(rr[0]), __uint_as_float(rr[1])); }
__device__ __forceinline__ float xhalf_other(float x, int hh) { auto rr = __builtin_amdgcn_permlane32_swap(__float_as_uint(x), __float_as_uint(x), false, false); return __uint_as_float(hh ? rr[0] : rr[1]); }
__device__ __forceinline__ f32x16 mfma32(bf16x8 a, bf16x8 b, f32x16 c) { return __builtin_amdgcn_mfma_f32_32x32x16_bf16(a, b, c, 0, 0, 0); }
__device__ __forceinline__ f32x4 mfma16(bf16x8 a, bf16x8 b, f32x4 c) { return __builtin_amdgcn_mfma_f32_16x16x32_bf16(a, b, c, 0, 0, 0); }
__device__ __forceinline__ f32x16 zero16() { f32x16 z;
#pragma unroll
    for (int i = 0; i < 16; ++i) z[i] = 0.f; return z; }

#define EPI_V8(v, acc, ai, bj, m) float v[8] = {acc[ai][bj][m][0][0], acc[ai][bj][m][0][1], acc[ai][bj][m][0][2], acc[ai][bj][m][0][3], acc[ai][bj][m][1][0], acc[ai][bj][m][1][1], acc[ai][bj][m][1][2], acc[ai][bj][m][1][3]}

struct EpiIn {
    static constexpr bool PERM = true, AFTER_DRAIN = false;
    unsigned char* ws; const float2* rope;
    __device__ __forceinline__ void operator()(const f32x4 (&acc)[2][2][4][2], const Unit& u, int wr, int wc, int fr, int fq) const {
        const int b = u.pm / 9, tq = u.pm % 9; const bool lat = tq != 0;
#pragma unroll
        for (int bj = 0; bj < 2; ++bj) {
            const int gt = u.pn * 2 + bj, cb = gt * 128 + wc * 32 + 8 * fq;
            int type, lc, pitch; size_t off;
            if (gt < 4) { type = 1; off = WS_AQ; lc = cb; pitch = 512; }
            else if (gt == 4) { type = 2; off = WS_AK; lc = cb - 512; pitch = 128; }
            else if (gt == 5) { type = 3; off = WS_AVT; lc = cb - 640; pitch = 128; }
            else if (gt < 10) { type = 4; off = WS_SAG; lc = cb - 768; pitch = 512; }
            else if (gt < 14) { type = 0; off = WS_BU; lc = cb - 1280; pitch = 512; }
            else if (gt < 18) { type = 4; off = WS_SBG; lc = cb - 1792; pitch = 512; }
            else if (gt < 22) { type = 1; off = WS_CQ; lc = cb - 2304; pitch = 512; }
            else if (gt < 26) { type = 2; off = WS_CK; lc = cb - 2816; pitch = 512; }
            else if (gt < 30) { type = 3; off = WS_CVT; lc = cb - 3328; pitch = 512; }
            else { type = 4; off = WS_SCG; lc = cb - 3840; pitch = 512; }
            bf16_t* dst = (bf16_t*)(ws + off);
            if (type == 1 || type == 2) {
                const float qsc = type == 1 ? QS : 1.f;
#pragma unroll
                for (int o = 0; o < (lat ? 1 : 0); ++o) {
                    if (wc & 1) {
#pragma unroll
                        for (int m = 0; m < 4; ++m) { const float2* rp = rope + (m * 16 + fr) * 16 + 8 * (fq & 1); float2 cs[8];
#pragma unroll
                            for (int i = 0; i < 8; ++i) cs[i] = rp[i];
#pragma unroll
                            for (int ai = 0; ai < 2; ++ai) { const int tau = tq * 256 + ai * 128 + wr * 64 + m * 16 + fr; const size_t row = (size_t)b * TOK + tau; EPI_V8(v, acc, ai, bj, m);
#pragma unroll
                                for (int i = 0; i < 8; ++i) { const float p = xhalf_other(v[i], fq >> 1); v[i] = (v[i] * cs[i].x + (fq >= 2 ? p : -p) * cs[i].y) * qsc; }
                                store8(dst + row * pitch + lc, v); } }
                    } else {
#pragma unroll
                        for (int ai = 0; ai < 2; ++ai) { const float2* rp = rope + ((tq - 1) * 4 + ai * 2 + wr) * 16 + 8 * (fq & 1); float2 cs[8];
#pragma unroll
                            for (int i = 0; i < 8; ++i) cs[i] = rp[i];
#pragma unroll
                            for (int m = 0; m < 4; ++m) { const int tau = tq * 256 + ai * 128 + wr * 64 + m * 16 + fr; const size_t row = (size_t)b * TOK + tau; EPI_V8(v, acc, ai, bj, m);
#pragma unroll
                                for (int i = 0; i < 8; ++i) { const float p = xhalf_other(v[i], fq >> 1); v[i] = (v[i] * cs[i].x + (fq >= 2 ? p : -p) * cs[i].y) * qsc; }
                                store8(dst + row * pitch + lc, v); } }
                    }
                }
                if (!lat) {
#pragma unroll
                    for (int ai = 0; ai < 2; ++ai)
#pragma unroll
                        for (int m = 0; m < 4; ++m) { const int tau = tq * 256 + ai * 128 + wr * 64 + m * 16 + fr; const size_t row = (size_t)b * TOK + tau; EPI_V8(v, acc, ai, bj, m);
#pragma unroll
                            for (int i = 0; i < 8; ++i) v[i] *= qsc;
                            store8(dst + row * pitch + lc, v); }
                }
            } else {
#pragma unroll
            for (int ai = 0; ai < 2; ++ai)
#pragma unroll
                for (int m = 0; m < 4; ++m) {
                    const int tau = tq * 256 + ai * 128 + wr * 64 + m * 16 + fr; const size_t row = (size_t)b * TOK + tau;
                    EPI_V8(v, acc, ai, bj, m);
                    if (type == 3) {
#pragma unroll
                        for (int i = 0; i < 8; ++i) dst[((size_t)b * pitch + lc + i) * TOK + tau] = f2bf(v[i]);
                    } else {
                        if (type == 4) {
#pragma unroll
                            for (int i = 0; i < 8; ++i) v[i] = siluf_(v[i]);
                        }
                        store8(dst + row * pitch + lc, v);
                    }
                }
            }
        }
    }
};
template <int MODE> struct EpiRow {
    static constexpr bool PERM = true, AFTER_DRAIN = false;
    bf16_t* O; int ldc; const bf16_t* X; const float* bias; const bf16_t* XC; int xcoff; bool octx; bool cfirst; unsigned char* wsm; bool bykind; bool two;
    __device__ __forceinline__ void operator()(const f32x4 (&acc)[2][2][4][2], const Unit& u, int wr, int wc, int fr, int fq) const {
        const bool ctxt = (u.pm % 9) == 0; const size_t crow0 = (size_t)(u.pm / 9) * 2048;
        const int xco = bykind ? (u.kind == 0 ? 1024 : (u.kind == 1 ? 0 : 2048)) : xcoff; const bool cf = bykind ? (u.kind == 0) : cfirst;
        const size_t mboff = (two && u.kind == 1) ? WS_MB2 : WS_MBUF; const bool skipy_all = two && u.kind == 0;
#pragma unroll
        for (int ai = 0; ai < 2; ++ai)
#pragma unroll
            for (int m = 0; m < 4; ++m) {
                const size_t row = (size_t)u.pm * 256 + ai * 128 + wr * 64 + m * 16 + fr;
#pragma unroll
                for (int bj = 0; bj < 2; ++bj) {
                    const int col = u.pn * 256 + bj * 128 + wc * 32 + 8 * fq; const size_t o = (MODE == 1 && octx ? row - crow0 : row) * ldc + col;
                    bf16_t* mp = (bf16_t*)(wsm + mboff) + row * 1024 + col;
                    EPI_V8(v, acc, ai, bj, m);
                    if (MODE == 1) {
#pragma unroll
                        for (int i = 0; i < 8; ++i) v[i] = sigmoidf_(v[i]);
                    } else if (MODE == 2 || MODE == 3) {
                        float mb[8]; load8((XC != nullptr && ctxt) ? XC + (row - crow0) * 3072 + xco + col : (const bf16_t*)mp, mb);
                        if (MODE == 3 && !(cf && ctxt) && !skipy_all) { float y[8]; load8(O + o, y);
#pragma unroll
                            for (int i = 0; i < 8; ++i) v[i] = y[i] + mb[i] * v[i];
                        } else {
#pragma unroll
                            for (int i = 0; i < 8; ++i) v[i] = mb[i] * v[i];
                        }
                    } else if (MODE == 4) {
                        float yb[8], sg[8]; load8(X + o, yb); load8(O + o, sg); const f32x4 b0 = *(const f32x4*)(bias + col), b1 = *(const f32x4*)(bias + col + 4);
                        const float bb[8] = {b0[0], b0[1], b0[2], b0[3], b1[0], b1[1], b1[2], b1[3]};
#pragma unroll
                        for (int i = 0; i < 8; ++i) v[i] = yb[i] * sigmoidf_(v[i] + bb[i]) * sg[i];
                    }
                    store8((MODE == 1 && !octx) ? mp : O + o, v);
                }
            }
    }
};
struct FlexOrder {
    pg8::StaticOrder s; int mode, nlat, nN, G, c, i0;
    __device__ __forceinline__ void init(int N, int G_, int c_, int mode_) { mode = mode_; nN = N / 256; nlat = 64 * nN; G = G_; c = c_; s.init(mode_ == 0 ? NROW : 16384, N, G_, c_);
        i0 = 0; if (mode_ == 4 || mode_ == 5) { i0 = (nlat - c_ + G_ - 1) / G_; if (i0 < 0) i0 = 0; } if (mode_ == 3) { c = ((c_ - (G_ == 256 ? 32 : 144)) % G_ + G_) % G_; } }
    __device__ __forceinline__ bool next(int i, Unit& u) const {
        u.kind = 0;
        if (mode == 0) return s.next(i, u);
        if (mode == 3) { const long e = (long)i * G + c; if (e >= 8 * nN) return false; u.pm = 9 * (int)(e / nN); u.pn = (int)(e % nN); return true; }
        if (mode == 6) { if (!s.next(i >> 1, u)) return false; u.pm = (u.pm >> 3) * 9 + 1 + (u.pm & 7); u.kind = i & 1; return true; }
        if (mode == 5) { const long L5 = (long)(i / 3 + i0) * G + c; const int e = (int)(L5 - nlat); if (e < 0 || e >= 8 * nN) return false; u.pm = 9 * (e / nN); u.pn = e % nN; u.kind = i % 3; return true; }
        const long L = (long)(i + i0) * G + c;
        if (mode == 1 || (mode == 2 && L < nlat)) { if (!s.next(i, u)) return false; u.pm = (u.pm >> 3) * 9 + 1 + (u.pm & 7); return true; }
        const int e = (int)(L - nlat); if (e < 0 || e >= 8 * nN) return false;
        u.pm = 9 * (e / nN); u.pn = e % nN; return true;
    }
    __device__ __forceinline__ void a_ready(const Unit&) const {}
    __device__ __forceinline__ void done(const Unit&) const {}
};
__device__ __forceinline__ void transpose_item(const float* W, int K, int N, bf16_t* WT, LAS float* scr, int item, int lane) {
    const int nblk = N / 32, kb = item / nblk, nb = item % nblk, k0 = 64 * kb, n0 = 32 * nb;
#pragma unroll 8
    for (int i = 0; i < 32; ++i) { const int kk = 2 * i + (lane >> 5); scr[kk * 33 + (lane & 31)] = W[(size_t)(k0 + kk) * N + n0 + (lane & 31)]; }
    asm volatile("s_waitcnt lgkmcnt(0)" ::: "memory");
    const int c = lane & 7;
#pragma unroll
    for (int j = 0; j < 4; ++j) { const int n = (lane >> 3) + 8 * j; const LAS float* s = scr + (8 * c) * 33 + n;
        u32x4 o; o.x = pk2(s[0 * 33], s[1 * 33]); o.y = pk2(s[2 * 33], s[3 * 33]); o.z = pk2(s[4 * 33], s[5 * 33]); o.w = pk2(s[6 * 33], s[7 * 33]);
        *(u32x4*)(WT + (size_t)(n0 + n) * K + k0 + 8 * c) = o; }
    asm volatile("s_waitcnt lgkmcnt(0)" ::: "memory");
}
__device__ __forceinline__ void weights_layer(const Args& a, int l, LAS unsigned char* lds, int gw, int ngw, int wave, int lane, int part  ) {
    LAS float* scr = (LAS float*)(lds + wave * 16384);
    bf16_t* W = (bf16_t*)(a.ws + WS_W);
    constexpr int I_IN = 16 * 232, I_O = 8 * 32, I_OUT = 16 * 32, I_G = 8 * 16, NIT = I_IN + 3 * I_O + I_OUT + I_G;
    for (int it = gw; it < NIT; it += ngw) {
        int r = it;
        if (part == 1 && (r < I_IN + 3 * I_O || r >= I_IN + 3 * I_O + I_OUT)) continue;
        if (r < I_IN) { transpose_item(a.in[I_WIN] + (size_t)l * 1024 * 7424, 1024, 7424, W + W_IN, scr, r, lane); continue; } r -= I_IN;
        if (r < I_O) { transpose_item(a.in[I_WOA] + (size_t)l * 512 * 1024, 512, 1024, W + W_OA, scr, r, lane); continue; } r -= I_O;
        if (r < I_O) { transpose_item(a.in[I_WOB] + (size_t)l * 512 * 1024, 512, 1024, W + W_OB, scr, r, lane); continue; } r -= I_O;
        if (r < I_O) { transpose_item(a.in[I_WOC] + (size_t)l * 512 * 1024, 512, 1024, W + W_OC, scr, r, lane); continue; } r -= I_O;
        if (r < I_OUT) { if (part != 0) transpose_item(a.in[I_WOUT] + (size_t)l * 1024 * 1024, 1024, 1024, W + W_OUT, scr, r, lane); continue; } r -= I_OUT;
        if (part == 1) continue;
        transpose_item(a.in[I_WGLU] + (size_t)l * 512 * 512, 512, 512, W + W_GLU, scr, r, lane);
    }
}
__device__ __forceinline__ const float* h_src(const Args& a, int layer, int b, int tau) {
    if (layer == 0) return tau < 256 ? a.in[I_CTX] + ((size_t)b * 256 + tau) * DM : a.in[I_X] + ((size_t)b * 2048 + tau - 256) * DM;
    return tau < 256 ? (const float*)(a.ws + WS_H1C) + ((size_t)b * 256 + tau) * DM : a.out + ((size_t)b * 2048 + tau - 256) * DM;
}
__device__ __forceinline__ void hn_store(const f32x4 (&v)[4], const float* mod, const float* nw, bf16_t* dst, int lane) {
    float ss = 0.f;
#pragma unroll
    for (int j = 0; j < 4; ++j) ss += (v[j][0] * v[j][0] + v[j][1] * v[j][1]) + (v[j][2] * v[j][2] + v[j][3] * v[j][3]);
    const float r = 1.f / sqrtf(wave_sum(ss) * (1.f / DM) + 1e-6f);
#pragma unroll
    for (int j = 0; j < 4; ++j) { const int c = 4 * (lane + 64 * j); const f32x4 w = *(const f32x4*)(nw + c), sh = *(const f32x4*)(mod + c), sc = *(const f32x4*)(mod + 1024 + c);
        const f32x4 o = v[j] * r * w * (1.f + sc) + sh; u32x2 pk; pk.x = pk2(o[0], o[1]); pk.y = pk2(o[2], o[3]); *(u32x2*)(dst + c) = pk; }
}

__device__ __forceinline__ void phase_p0(const Args& a, LAS unsigned char* lds, int tid, int wave, int lane) {
    const float* c = a.in[I_C]; const float* cctx = a.in[I_CCTX];
    float* MOD = (float*)(a.ws + WS_TAB + T_MOD);
    for (int vb = blockIdx.x; vb < 210; vb += gridDim.x) {
        if (vb < 192) {
            const int l = vb / 96, n0 = (vb % 96) * 32;
            LAS float* sc = (LAS float*)lds; LAS float* red = sc + 9 * 1024;
            for (int i = tid; i < 9 * 1024; i += 512) { const float v = i < 8192 ? c[i] : cctx[i - 8192]; sc[i] = v / (1.f + expf(-v)); }
            __syncthreads();
            const int s = tid >> 5, nn = tid & 31; float acc[9];
#pragma unroll
            for (int j = 0; j < 9; ++j) acc[j] = 0.f;
            const float* wp = a.in[I_WMOD] + ((size_t)l * 1024 + s * 64) * 3072 + n0 + nn;
#pragma unroll 16
            for (int k = 0; k < 64; ++k) { const float w = wp[(size_t)k * 3072];
#pragma unroll
                for (int j = 0; j < 9; ++j) acc[j] += sc[j * 1024 + s * 64 + k] * w; }
#pragma unroll
            for (int j = 0; j < 9; ++j) red[(s * 9 + j) * 32 + nn] = acc[j];
            __syncthreads();
            if (tid < 288) { const int j = tid >> 5; float t = a.in[I_BMOD][l * 3072 + n0 + nn];
#pragma unroll
                for (int s2 = 0; s2 < 16; ++s2) t += red[(s2 * 9 + j) * 32 + nn];
                MOD[(l * 9 + j) * 3072 + n0 + nn] = t; }
            __syncthreads();
        } else if (vb < 208) {
            const int idx = (vb - 192) * 512 + tid, l = idx >> 12, dir = (idx >> 11) & 1, g = (idx >> 6) & 31, p = idx & 63;
            const int ld = l * 2 + dir;
            const double dt = exp((double)a.in[I_LOGDT][ld * 32 + g]);
            const double are = a.in[I_ARE][(ld * 32 + g) * 64 + p], aim = a.in[I_AIM][(ld * 32 + g) * 64 + p];
            const double mag = exp(are * dt), abr = mag * cos(aim * dt), abi = mag * sin(aim * dt);
            const double den = are * are + aim * aim, nr = abr - 1.0, ni = abi;
            const double fre = (nr * are + ni * aim) / den, fim = (ni * are - nr * aim) / den;
            bf16_t* BbT = (bf16_t*)(a.ws + WS_TAB + T_BBT) + (size_t)(ld * 32 + g) * 2048;
            const float* bre = a.in[I_BRE] + ((size_t)(ld * 32 + g) * 64 + p) * 16; const float* bim = a.in[I_BIM] + ((size_t)(ld * 32 + g) * 64 + p) * 16;
            for (int h = 0; h < 16; ++h) { const double br = bre[h], bi = bim[h];
                BbT[(0 * 64 + p) * 16 + h] = f2bf((float)(fre * br - fim * bi)); BbT[(1 * 64 + p) * 16 + h] = f2bf((float)(fre * bi + fim * br)); }
            float* Ap = (float*)(a.ws + WS_TAB + T_AP) + (size_t)(ld * 32 + g) * 384;
#pragma unroll
            for (int k = 0; k < 3; ++k) { const double n = (k == 0 ? 1.0 : (k == 1 ? 16.0 : 32.0)), mg = exp(n * are * dt); Ap[(2 * k) * 64 + p] = (float)(mg * cos(n * aim * dt)); Ap[(2 * k + 1) * 64 + p] = (float)(mg * sin(n * aim * dt)); }
            bf16_t* Cc = (bf16_t*)(a.ws + WS_TAB + T_CC) + (size_t)(ld * 32 + g) * 2048;
            const float* cre = a.in[I_CRE] + (size_t)(ld * 32 + g) * 1024; const float* cim = a.in[I_CIM] + (size_t)(ld * 32 + g) * 1024;
            const int pl = p & 31, pb = p >> 5;
            for (int h = 0; h < 16; ++h) { Cc[h * 128 + 4 * pl + 2 * pb] = f2bf(cre[h * 64 + p]); Cc[h * 128 + 4 * pl + 2 * pb + 1] = f2bf(-cim[h * 64 + p]); }
        } else if (vb == 208) {
            float2* rope = (float2*)(a.ws + WS_TAB + T_ROPE);
            for (int i = tid; i < 1024; i += 512) { const int pos = i >> 4, f = i & 15; const float inv = (float)pow(10000.0, -(double)f / 16.0); const float ang = (float)pos * inv;
                rope[i] = make_float2((float)cos((double)ang), (float)sin((double)ang)); }
        } else {
            if (tid < 2) { const int l = tid; float s1 = 0.f, s2 = 0.f;
                for (int i = 0; i < 64; ++i) { s1 += a.in[I_LQ1][l * 64 + i] * a.in[I_LK1][l * 64 + i]; s2 += a.in[I_LQ2][l * 64 + i] * a.in[I_LK2][l * 64 + i]; }
                const float lam_init = 0.8f - 0.6f * expf(-0.3f * (float)l);
                ((float*)(a.ws + WS_TAB + T_LAM))[l] = expf(s1) - expf(s2) + lam_init; }
        }
    }
    __syncthreads();
    weights_layer(a, 0, lds, blockIdx.x * 8 + wave, gridDim.x * 8, wave, lane, 2);
}
struct RowPar { f32x4 w[4], a[4], c[4]; };
__device__ __forceinline__ void load_prepar(RowPar& P, const float* mod, const float* nw, int lane) {
#pragma unroll
    for (int j = 0; j < 4; ++j) { const int c = 4 * (lane + 64 * j); P.w[j] = *(const f32x4*)(nw + c); P.a[j] = *(const f32x4*)(mod + c); P.c[j] = 1.f + *(const f32x4*)(mod + 1024 + c); }
}
__device__ __forceinline__ void hn_store_p(const f32x4 (&v)[4], const RowPar& P, bf16_t* dst, int lane) {
    float ss = 0.f;
#pragma unroll
    for (int j = 0; j < 4; ++j) ss += (v[j][0] * v[j][0] + v[j][1] * v[j][1]) + (v[j][2] * v[j][2] + v[j][3] * v[j][3]);
    const float r = 1.f / sqrtf(wave_sum(ss) * (1.f / DM) + 1e-6f);
#pragma unroll
    for (int j = 0; j < 4; ++j) { const int c = 4 * (lane + 64 * j); const f32x4 o = v[j] * r * P.w[j] * P.c[j] + P.a[j]; u32x2 pk; pk.x = pk2(o[0], o[1]); pk.y = pk2(o[2], o[3]); *(u32x2*)(dst + c) = pk; }
}
__device__ __forceinline__ void phase_hn0(const Args& a, int wave, int lane) {
    const float* MOD = (const float*)(a.ws + WS_TAB + T_MOD);
    const int gw = blockIdx.x * 8 + wave, wpb = (gridDim.x * 8) / 8, b = gw / wpb, r0 = gw % wpb;
    if (b >= 8) return;
    RowPar P; int cls = -1;
    int tau = r0;
    f32x4 vn[4];
    if (tau < TOK) { const f32x4* src = (const f32x4*)h_src(a, 0, b, tau);
#pragma unroll
        for (int j = 0; j < 4; ++j) vn[j] = src[lane + 64 * j]; }
    for (; tau < TOK; tau += wpb) {
        f32x4 v[4];
#pragma unroll
        for (int j = 0; j < 4; ++j) v[j] = vn[j];
        const int c = tau < 256 ? 1 : 0;
        if (c != cls) { load_prepar(P, MOD + (size_t)(c ? 8 : b) * 3072, a.in[I_NPRE], lane); cls = c; }
        const int tn = tau + wpb;
        if (tn < TOK) { const f32x4* src = (const f32x4*)h_src(a, 0, b, tn);
#pragma unroll
            for (int j = 0; j < 4; ++j) vn[j] = src[lane + 64 * j]; }
        hn_store_p(v, P, (bf16_t*)(a.ws + WS_HN) + ((size_t)b * TOK + tau) * DM, lane);
    }
}
__device__ __forceinline__ void phase_resid(const Args& a, int layer, LAS unsigned char* lds, int wave, int lane) {
    const float* MOD = (const float*)(a.ws + WS_TAB + T_MOD);
    const bf16_t* YO = (const bf16_t*)(a.ws + WS_YO);
    const float* npost = a.in[I_NPOST] + layer * DM;
    const int gw = blockIdx.x * 8 + wave, wpb = (gridDim.x * 8) / 8, b = gw / wpb, r0 = gw % wpb;
    if (b < 8) {
        RowPar Q, P; int cls = -1;
        int tau = r0;
        while (tau < TOK && layer == 1 && tau < 256) tau += wpb;
        f32x4 hn_[4]; u32x2 yn_[4];
        if (tau < TOK) { const f32x4* src = (const f32x4*)h_src(a, layer, b, tau); const size_t row = (size_t)b * TOK + tau;
#pragma unroll
            for (int j = 0; j < 4; ++j) { hn_[j] = src[lane + 64 * j]; yn_[j] = *(const u32x2*)(YO + row * DM + 4 * (lane + 64 * j)); } }
        while (tau < TOK) {
            const size_t row = (size_t)b * TOK + tau;
            f32x4 h[4], y[4]; float ss = 0.f;
#pragma unroll
            for (int j = 0; j < 4; ++j) { h[j] = hn_[j]; const u32x2 w = yn_[j];
                y[j] = (f32x4){bflo(w.x), bfhi(w.x), bflo(w.y), bfhi(w.y)}; ss += (y[j][0] * y[j][0] + y[j][1] * y[j][1]) + (y[j][2] * y[j][2] + y[j][3] * y[j][3]); }
            const int c = tau < 256 ? 1 : 0;
            if (c != cls) { const float* mod = MOD + (size_t)(layer * 9 + (c ? 8 : b)) * 3072;
#pragma unroll
                for (int j = 0; j < 4; ++j) { const int cc = 4 * (lane + 64 * j); Q.w[j] = *(const f32x4*)(npost + cc); Q.a[j] = *(const f32x4*)(mod + 2048 + cc); }
                if (layer == 0) load_prepar(P, MOD + (size_t)(9 + (c ? 8 : b)) * 3072, a.in[I_NPRE] + DM, lane);
                cls = c; }
            const int tn = tau + wpb;
            if (tn < TOK) { const f32x4* src = (const f32x4*)h_src(a, layer, b, tn); const size_t rn = (size_t)b * TOK + tn;
#pragma unroll
                for (int j = 0; j < 4; ++j) { hn_[j] = src[lane + 64 * j]; yn_[j] = *(const u32x2*)(YO + rn * DM + 4 * (lane + 64 * j)); } }
            f32x4* dst = (f32x4*)(tau < 256 ? (float*)(a.ws + WS_H1C) + ((size_t)b * 256 + tau) * DM : a.out + ((size_t)b * 2048 + tau - 256) * DM);
            const float r = 1.f / sqrtf(wave_sum(ss) * (1.f / DM) + 1e-6f);
#pragma unroll
            for (int j = 0; j < 4; ++j) { h[j] = h[j] + Q.a[j] * (y[j] * r * Q.w[j]); dst[lane + 64 * j] = h[j]; }
            if (layer == 0) hn_store_p(h, P, (bf16_t*)(a.ws + WS_HN) + row * DM, lane);
            tau = tn;
        }
    }
    if (layer == 0) { __syncthreads(); weights_layer(a, 1, lds, blockIdx.x * 8 + wave, gridDim.x * 8, wave, lane, 1); }
}

template <bool WIN>
__device__ __forceinline__ f32x16 attn_qk(const f32x16& negm, const bf16x8 (&qf)[4], const LAS unsigned char* kb, int mode, int ql, int hh) {
    bf16x8 kf[4];
#pragma unroll
    for (int d0 = 0; d0 < 4; ++d0) kf[d0] = *(const LAS bf16x8*)(kb + d0 * 32);
    f32x16 s = negm;
#pragma unroll
    for (int d0 = 0; d0 < 4; ++d0) s = mfma32(kf[d0], qf[d0], s);
    if (WIN) {
        if (mode != 0) {
#pragma unroll
            for (int r = 0; r < 16; ++r) { const int j = (r & 3) + 4 * ((r >> 2) & 1) + 8 * hh + 16 * (r >> 3); const bool ok = mode == 1 ? (j >= ql) : (j <= ql); if (!ok) s[r] = -INFINITY; }
        }
    }
    return s;
}
template <int NDB, int VP>
__device__ __forceinline__ void attn_pv(f32x16 (&o)[NDB], f32x16& negm, float& mref, float& lsum, int& first, f32x16& s, f32x16& s2, const LAS unsigned char* vb) {
    constexpr int NEARLY = NDB > 3 ? 3 : NDB;
    bf16x8 vf[NDB][2];
#pragma unroll
    for (int db = 0; db < NEARLY; ++db) { vf[db][0] = *(const LAS bf16x8*)(vb + db * 32 * VP); vf[db][1] = *(const LAS bf16x8*)(vb + db * 32 * VP + 32); }
    __builtin_amdgcn_sched_barrier(0);
    float mx = fmaxf(s[0], s[1]);
#pragma unroll
    for (int r = 2; r < 16; ++r) mx = fmaxf(mx, s[r]);
    mx = xhalf_max(mx);
    if (__any((first != 0) || (mx > 8.f))) {
        const float delta = first ? mx : fmaxf(mx, 0.f), alpha = first ? 1.f : __builtin_amdgcn_exp2f(-delta);
        mref += delta; lsum *= alpha;
#pragma unroll
        for (int r = 0; r < 16; ++r) { s[r] -= delta; s2[r] -= delta; negm[r] = -mref; }
#pragma unroll
        for (int db = 0; db < NDB; ++db) o[db] = o[db] * alpha;
        first = 0;
    }
    float ps = 0.f;
#pragma unroll
    for (int r = 0; r < 16; ++r) { s[r] = __builtin_amdgcn_exp2f(s[r]); ps += s[r]; }
    lsum += ps;
    u32x4 w0, w1; w0.x = pk2(s[0], s[1]); w0.y = pk2(s[2], s[3]); w0.z = pk2(s[4], s[5]); w0.w = pk2(s[6], s[7]);
    w1.x = pk2(s[8], s[9]); w1.y = pk2(s[10], s[11]); w1.z = pk2(s[12], s[13]); w1.w = pk2(s[14], s[15]);
    const bf16x8 pb0 = __builtin_bit_cast(bf16x8, w0), pb1 = __builtin_bit_cast(bf16x8, w1);
#pragma unroll
    for (int db = NEARLY; db < NDB; ++db) { vf[db][0] = *(const LAS bf16x8*)(vb + db * 32 * VP); vf[db][1] = *(const LAS bf16x8*)(vb + db * 32 * VP + 32); }
#pragma unroll
    for (int db = 0; db < NDB; ++db) { o[db] = mfma32(vf[db][0], pb0, o[db]); o[db] = mfma32(vf[db][1], pb1, o[db]); }
}
template <int NDB, int VP, bool WIN>
__device__ __forceinline__ void attn_tile(f32x16 (&o)[NDB], f32x16& negm, float& mref, float& lsum, int& first, const bf16x8 (&qf)[4],
                                          const LAS unsigned char* kb, const LAS unsigned char* vb, int mode  , int ql, int hh) {
    f32x16 s = attn_qk<WIN>(negm, qf, kb, mode, ql, hh), dummy = zero16();
    attn_pv<NDB, VP>(o, negm, mref, lsum, first, s, dummy, vb);
}
constexpr int DKP = 272, DVP = 144, DST_K = 64 * DKP, DST = DST_K + 128 * DVP;
__device__ __forceinline__ void diff_task(const Args& a, int layer, int b, int hc, int qg, LAS unsigned char* lds, int tid, int wave, int lane) {
    const int sub = wave >> 2, qt = qg * 4 + (wave & 3), ql = lane & 31, hh = lane >> 5;
    bf16_t* Q = (bf16_t*)(a.ws + WS_CQ); const bf16_t* SCG = (const bf16_t*)(a.ws + WS_SCG);
    const size_t qrow = (size_t)b * TOK + qt * 32 + ql;
    bf16x8 qf[4];
#pragma unroll
    for (int d0 = 0; d0 < 4; ++d0) qf[d0] = *(const bf16x8*)(Q + qrow * 512 + hc * 128 + sub * 64 + d0 * 16 + hh * 8);
    const int nst = qg < 2 ? 4 : 36;
    const unsigned char* gK = (const unsigned char*)(a.ws + WS_CK) + (((size_t)b * TOK + (tid >> 4)) * 512 + hc * 128) * 2 + (tid & 15) * 16;
    const unsigned char* gV = (const unsigned char*)(a.ws + WS_CVT) + (((size_t)b * 512 + hc * 128 + (tid >> 3)) * TOK) * 2 + (tid & 7) * 16;
    const int lK = (tid >> 4) * DKP + (tid & 15) * 16, lV = DST_K + (tid >> 3) * DVP + (tid & 7) * 16;
    u32x4 gk0, gk1, gv0, gv1;
#define DIFF_LOAD(st) do { gk0 = *(const u32x4*)(gK + (size_t)(st) * 64 * 1024); gk1 = *(const u32x4*)(gK + (size_t)(st) * 64 * 1024 + 32 * 1024); \
                           gv0 = *(const u32x4*)(gV + (size_t)(st) * 128); gv1 = *(const u32x4*)(gV + (size_t)(st) * 128 + (size_t)64 * TOK * 2); } while (0)
#define DIFF_WRITE(buf) do { LAS unsigned char* d_ = lds + (buf) * DST; *(LAS u32x4*)(d_ + lK) = gk0; *(LAS u32x4*)(d_ + lK + 32 * DKP) = gk1; \
                             *(LAS u32x4*)(d_ + lV) = gv0; *(LAS u32x4*)(d_ + lV + 64 * DVP) = gv1; } while (0)
    DIFF_LOAD(0); DIFF_WRITE(0);
    __syncthreads();
    const int kperm = (ql & ~12) | ((ql & 4) << 1) | ((ql & 8) >> 1);
    const int koff = kperm * DKP + (sub * 64 + hh * 8) * 2, voff = DST_K + ql * DVP + hh * 16;
    float mref = 0.f, lsum = 0.f; int first = 1;
    f32x16 negm = zero16();
    f32x16 o[4]; o[0] = zero16(); o[1] = zero16(); o[2] = zero16(); o[3] = zero16();
#pragma unroll 1
    for (int st = 0; st < nst; ++st) {
        if (st + 1 < nst) DIFF_LOAD(st + 1);
        const LAS unsigned char* cur = lds + (st & 1) * DST;
        { f32x16 s0 = attn_qk<false>(negm, qf, cur + koff, 0, ql, hh), s1 = attn_qk<false>(negm, qf, cur + koff + 32 * DKP, 0, ql, hh), dummy = zero16();
          attn_pv<4, DVP>(o, negm, mref, lsum, first, s0, s1, cur + voff);
          attn_pv<4, DVP>(o, negm, mref, lsum, first, s1, dummy, cur + voff + 64); }
        if (st + 1 < nst) DIFF_WRITE((st + 1) & 1);
        __syncthreads();
    }
#undef DIFF_LOAD
#undef DIFF_WRITE
    const float l = lsum + __shfl_xor(lsum, 32);
    const float lam = ((const float*)(a.ws + WS_TAB + T_LAM))[layer], lam_init = 0.8f - 0.6f * expf(-0.3f * (float)layer);
    LAS float* X = (LAS float*)lds + (wave & 3) * 4096;
    if (sub == 1) { const float sc = lam / l;
#pragma unroll
        for (int db = 0; db < 4; ++db)
#pragma unroll
            for (int r = 0; r < 16; ++r) { const int e = db * 32 + (r & 3) + 8 * (r >> 2) + 4 * hh; X[e * 32 + ql] = o[db][r] * sc; } }
    __syncthreads();
    if (sub == 0) { const float inv = 1.f / l; float ss = 0.f;
#pragma unroll
        for (int db = 0; db < 4; ++db)
#pragma unroll
            for (int r = 0; r < 16; ++r) { const int e = db * 32 + (r & 3) + 8 * (r >> 2) + 4 * hh; const float v = o[db][r] * inv - X[e * 32 + ql]; o[db][r] = v; ss += v * v; }
        ss += __shfl_xor(ss, 32);
        const float rs = (1.f - lam_init) / sqrtf(ss * (1.f / 128.f) + 1e-6f);
        const float* sw = a.in[I_SUBLN] + layer * 128;
#pragma unroll
        for (int db = 0; db < 4; ++db)
#pragma unroll
            for (int rg = 0; rg < 4; ++rg) { const int e = db * 32 + 8 * rg + 4 * hh; const size_t off = qrow * 512 + hc * 128 + e; const u32x2 g = *(const u32x2*)(SCG + off); const f32x4 w4 = *(const f32x4*)(sw + e);
                u32x2 w; w.x = pk2(o[db][4 * rg] * rs * w4[0] * bflo(g.x), o[db][4 * rg + 1] * rs * w4[1] * bfhi(g.x)); w.y = pk2(o[db][4 * rg + 2] * rs * w4[2] * bflo(g.y), o[db][4 * rg + 3] * rs * w4[3] * bfhi(g.y));
                *(u32x2*)(Q + off) = w; } }
    __syncthreads();
}

constexpr int SKP = 144, SST_K = 64 * SKP, SST = 2 * SST_K;
__device__ __forceinline__ void swa_task(const Args& a, int layer, int b, int kvh, int qp, LAS unsigned char* lds, int tid, int wave, int lane) {
    const int h = kvh * 4 + (wave & 3), qt0 = qp * 2, qt = qt0 + (wave >> 2), ql = lane & 31, hh = lane >> 5;
    bf16_t* Q = (bf16_t*)(a.ws + WS_AQ); const bf16_t* SAG = (const bf16_t*)(a.ws + WS_SAG);
    const size_t qrow = (size_t)b * TOK + qt * 32 + ql;
    bf16x8 qf[4];
#pragma unroll
    for (int d0 = 0; d0 < 4; ++d0) qf[d0] = *(const bf16x8*)(Q + qrow * 512 + h * 64 + d0 * 16 + hh * 8);
    int lo = 8, nlat = 0; if (qt0 >= 8) { lo = qt0 - 4 < 8 ? 8 : qt0 - 4; const int hi = qt0 + 5 > 71 ? 71 : qt0 + 5; nlat = (hi - lo + 1) >> 1; }
    const int nst = 4 + nlat;
    const unsigned char* gK = (const unsigned char*)(a.ws + WS_AK) + (((size_t)b * TOK + (tid >> 3)) * 128 + kvh * 64) * 2 + (tid & 7) * 16;
    const unsigned char* gV = (const unsigned char*)(a.ws + WS_AVT) + (((size_t)b * 128 + kvh * 64 + (tid >> 3)) * TOK) * 2 + (tid & 7) * 16;
    const int lK = (tid >> 3) * SKP + (tid & 7) * 16;
    u32x4 gk, gv;
#define SWA_KEY0(st) ((st) < 4 ? 64 * (st) : 32 * lo + 64 * ((st) - 4))
#define SWA_LOAD(st) do { const int k0_ = SWA_KEY0(st); gk = *(const u32x4*)(gK + (size_t)k0_ * 256); gv = *(const u32x4*)(gV + (size_t)k0_ * 2); } while (0)
#define SWA_WRITE(buf) do { LAS unsigned char* d_ = lds + (buf) * SST; *(LAS u32x4*)(d_ + lK) = gk; *(LAS u32x4*)(d_ + SST_K + lK) = gv; } while (0)
    SWA_LOAD(0); SWA_WRITE(0);
    __syncthreads();
    const int kperm = (ql & ~12) | ((ql & 4) << 1) | ((ql & 8) >> 1);
    const int koff = kperm * SKP + hh * 16, voff = SST_K + ql * SKP + hh * 16;
    float mref = a.in[I_SINK][layer * 8 + h] * LOG2E, lsum = hh == 0 ? 1.f : 0.f; int first = 0;
    f32x16 negm;
#pragma unroll
    for (int r = 0; r < 16; ++r) negm[r] = -mref;
    f32x16 o[2]; o[0] = zero16(); o[1] = zero16();
#pragma unroll 1
    for (int st = 0; st < nst; ++st) {
        if (st + 1 < nst) SWA_LOAD(st + 1);
        const LAS unsigned char* cur = lds + (st & 1) * SST;
        const int kt0 = SWA_KEY0(st) >> 5;
#pragma unroll
        for (int j = 0; j < 2; ++j) {
            const int kt = kt0 + j; int mode = 0; bool need = true;
            if (st >= 4) { need = (kt >= qt - 4) && (kt <= qt + 4); mode = kt == qt - 4 ? 1 : (kt == qt + 4 ? 2 : 0); }
            if (need) attn_tile<2, SKP, true>(o, negm, mref, lsum, first, qf, cur + koff + j * 32 * SKP, cur + voff + j * 64, mode, ql, hh);
        }
        if (st + 1 < nst) SWA_WRITE((st + 1) & 1);
        __syncthreads();
    }
#undef SWA_KEY0
#undef SWA_LOAD
#undef SWA_WRITE
    const float inv = 1.f / (lsum + __shfl_xor(lsum, 32));
#pragma unroll
    for (int db = 0; db < 2; ++db)
#pragma unroll
        for (int rg = 0; rg < 4; ++rg) { const size_t off = qrow * 512 + h * 64 + db * 32 + 8 * rg + 4 * hh; const u32x2 g = *(const u32x2*)(SAG + off);
            u32x2 w; w.x = pk2(o[db][4 * rg] * inv * bflo(g.x), o[db][4 * rg + 1] * inv * bfhi(g.x)); w.y = pk2(o[db][4 * rg + 2] * inv * bflo(g.y), o[db][4 * rg + 3] * inv * bfhi(g.y));
            *(u32x2*)(Q + off) = w; }
}

struct Cx { float r, i; };
__device__ __forceinline__ Cx cmuladd(Cx a, Cx s, float br, float bi) { Cx o; o.r = a.r * s.r - a.i * s.i + br; o.i = a.r * s.i + a.i * s.r + bi; return o; }
__device__ __forceinline__ const bf16_t* s5_uptr(const bf16_t* U, int b, int g, int dir, int J, int lane) {
    const int mrow = lane & 31, kh = lane >> 5, t = 16 * ((mrow >> 2) & 1) + (mrow & 3) + 4 * (mrow >> 3), tau = dir == 0 ? 32 * J + t : 32 * J + 31 - t;
    return U + ((size_t)b * TOK + tau) * 512 + g * 16 + kh * 8;
}
__device__ __forceinline__ void s5_chain_wave(const Args& a, int layer, int cw  , int lane) {
    const int combo = cw & 63, g = combo >> 1, dir = combo & 1, b = cw >> 6, ql = lane & 31, hh = lane >> 5;
    const int ld = layer * 2 + dir;
    const bf16_t* BbT = (const bf16_t*)(a.ws + WS_TAB + T_BBT) + (size_t)(ld * 32 + g) * 2048;
    const float* Ap = (const float*)(a.ws + WS_TAB + T_AP) + (size_t)(ld * 32 + g) * 384;
    const bf16_t* U = (const bf16_t*)(a.ws + WS_BU);
    bf16x8 bb[2][2]; Cx a1[2], a16[2], a32[2], hst[2];
#pragma unroll
    for (int ri = 0; ri < 2; ++ri)
#pragma unroll
        for (int pb = 0; pb < 2; ++pb) bb[ri][pb] = *(const bf16x8*)(BbT + ((ri * 64 + pb * 32 + ql) * 16 + hh * 8));
#pragma unroll
    for (int pb = 0; pb < 2; ++pb) { const int p = pb * 32 + ql; a1[pb].r = Ap[0 * 64 + p]; a1[pb].i = Ap[1 * 64 + p]; a16[pb].r = Ap[2 * 64 + p]; a16[pb].i = Ap[3 * 64 + p];
        a32[pb].r = Ap[4 * 64 + p]; a32[pb].i = Ap[5 * 64 + p]; hst[pb].r = 0.f; hst[pb].i = 0.f; }
    float* SC = (float*)(a.ws + WS_SC) + (((size_t)b * 32 + g) * 2 + dir) * 72 * 128;
    float* E0 = (float*)(a.ws + WS_E0) + (((size_t)b * 32 + g) * 2 + dir) * 72 * 128;
    bf16x8 un = *(const bf16x8*)s5_uptr(U, b, g, dir, dir == 0 ? 0 : 7, lane);
#pragma unroll 1
    for (int c = 0; c < 72; ++c) {
        const bf16x8 av = un;
        if (c + 1 < 72) { const int cn = c + 1; un = *(const bf16x8*)s5_uptr(U, b, g, dir, dir == 0 ? cn : (cn < 8 ? 7 - cn : 79 - cn), lane); }
#pragma unroll
        for (int pb = 0; pb < 2; ++pb) {
            const f32x16 br = mfma32(av, bb[0][pb], zero16()), bi = mfma32(av, bb[1][pb], zero16());
            Cx e = {0.f, 0.f};
#pragma unroll
            for (int r = 0; r < 16; ++r) e = cmuladd(a1[pb], e, br[r], bi[r]);
            Cx e0; e0.r = __shfl(e.r, ql); e0.i = __shfl(e.i, ql);
            const Cx sv = cmuladd(a16[pb], e0, e.r, e.i);
            Cx sl; sl.r = __shfl(sv.r, 32 + ql); sl.i = __shfl(sv.i, 32 + ql);
            if (hh == 1) { SC[c * 128 + pb * 32 + ql] = hst[pb].r; SC[c * 128 + 64 + pb * 32 + ql] = hst[pb].i; }
            else { E0[c * 128 + pb * 32 + ql] = e.r; E0[c * 128 + 64 + pb * 32 + ql] = e.i; }
            hst[pb] = cmuladd(a32[pb], hst[pb], sl.r, sl.i);
        }
    }
}
__device__ __forceinline__ void s5_pass3_wave(const Args& a, int layer, int gw, int ngw, LAS unsigned char* lds, int wave, int lane) {
    const int g = gw & 31, wi = gw >> 5, nwi = ngw >> 5, ql = lane & 31, hh = lane >> 5;
    if (wi >= nwi) return;
    LAS bf16_t* Hs = (LAS bf16_t*)(lds + wave * 8704);
    LAS bf16_t* Cl = (LAS bf16_t*)(lds + 69632 + wave * 8704);
    const bf16_t* U = (const bf16_t*)(a.ws + WS_BU);
    Cx a1[2][2], a16[2][2]; bf16x8 bb[2][2][2];
#pragma unroll
    for (int dir = 0; dir < 2; ++dir) {
        const int ld = layer * 2 + dir;
        const float* Ap = (const float*)(a.ws + WS_TAB + T_AP) + (size_t)(ld * 32 + g) * 384;
        const bf16_t* BbT = (const bf16_t*)(a.ws + WS_TAB + T_BBT) + (size_t)(ld * 32 + g) * 2048 + ql * 16 + hh * 8;
        const bf16_t* Cc = (const bf16_t*)(a.ws + WS_TAB + T_CC) + (size_t)(ld * 32 + g) * 2048;
#pragma unroll
        for (int pb = 0; pb < 2; ++pb) { const int p = pb * 32 + ql; a1[dir][pb].r = Ap[0 * 64 + p]; a1[dir][pb].i = Ap[1 * 64 + p]; a16[dir][pb].r = Ap[2 * 64 + p]; a16[dir][pb].i = Ap[3 * 64 + p];
            bb[dir][0][pb] = *(const bf16x8*)(BbT + pb * 512); bb[dir][1][pb] = *(const bf16x8*)(BbT + 1024 + pb * 512); }
#pragma unroll
        for (int q = 0; q < 4; ++q) { const int ch = lane + 64 * q, hrow = ch >> 4, c8 = ch & 15;
            *(LAS bf16x8*)(Cl + dir * 2176 + hrow * 136 + c8 * 8) = *(const bf16x8*)(Cc + hrow * 128 + c8 * 8); }
    }
    const int col = g * 16 + (lane & 15); const float dsk = a.in[I_SD][layer * 512 + col];
    bf16_t* YBF = (bf16_t*)(a.ws + WS_YBF);
    int it = wi;
    bf16x8 un0 = *(const bf16x8*)s5_uptr(U, it / 72, g, 0, it % 72, lane), un1 = *(const bf16x8*)s5_uptr(U, it / 72, g, 1, it % 72, lane);
#pragma unroll 1
    for (; it < 576; it += nwi) {
        const bf16x8 ua[2] = {un0, un1}; const int b = it / 72, J = it % 72;
        const int itn = it + nwi;
        const size_t row0 = (size_t)b * TOK + 32 * J + 4 * (lane >> 4);
        Cx hin[2][2], e0[2][2];
#pragma unroll
        for (int dir = 0; dir < 2; ++dir) {
            const int c = dir == 0 ? J : (J < 8 ? 7 - J : 79 - J);
            const size_t so = ((((size_t)b * 32 + g) * 2 + dir) * 72 + c) * 128;
            const float* SC = (const float*)(a.ws + WS_SC) + so; const float* E0 = (const float*)(a.ws + WS_E0) + so;
#pragma unroll
            for (int pb = 0; pb < 2; ++pb) { hin[dir][pb].r = SC[pb * 32 + ql]; hin[dir][pb].i = SC[64 + pb * 32 + ql]; e0[dir][pb].r = E0[pb * 32 + ql]; e0[dir][pb].i = E0[64 + pb * 32 + ql]; }
        }
        unsigned short ue[2][4];
#pragma unroll
        for (int rb = 0; rb < 2; ++rb)
#pragma unroll
            for (int i = 0; i < 4; ++i) ue[rb][i] = U[(row0 + 16 * rb + i) * 512 + col];
        if (itn < 576) { un0 = *(const bf16x8*)s5_uptr(U, itn / 72, g, 0, itn % 72, lane); un1 = *(const bf16x8*)s5_uptr(U, itn / 72, g, 1, itn % 72, lane); }
        f32x4 acc[2]; acc[0] = (f32x4){0.f, 0.f, 0.f, 0.f}; acc[1] = acc[0];
#pragma unroll
        for (int dir = 0; dir < 2; ++dir) {
#pragma unroll
            for (int pb = 0; pb < 2; ++pb) {
                const f32x16 bur = mfma32(ua[dir], bb[dir][0][pb], zero16()), bui = mfma32(ua[dir], bb[dir][1][pb], zero16());
                const Cx mid = cmuladd(a16[dir][pb], hin[dir][pb], e0[dir][pb].r, e0[dir][pb].i);
                Cx st = hh == 0 ? hin[dir][pb] : mid;
                LAS bf16_t* hp = Hs + (dir == 0 ? 16 * hh : 31 - 16 * hh) * 136 + 4 * ql + 2 * pb; const int hstep = dir == 0 ? 136 : -136;
#pragma unroll
                for (int r = 0; r < 16; ++r) { st = cmuladd(a1[dir][pb], st, bur[r], bui[r]); *(LAS unsigned*)hp = pk2(st.r, st.i); hp += hstep; }
            }
            asm volatile("" ::: "memory");
#pragma unroll
            for (int rb = 0; rb < 2; ++rb)
#pragma unroll
                for (int ks = 0; ks < 4; ++ks) { const bf16x8 af = *(const LAS bf16x8*)(Hs + (rb * 16 + (lane & 15)) * 136 + 32 * ks + 8 * (lane >> 4));
                    const bf16x8 cf = *(const LAS bf16x8*)(Cl + dir * 2176 + (lane & 15) * 136 + 32 * ks + 8 * (lane >> 4)); acc[rb] = mfma16(af, cf, acc[rb]); }
            asm volatile("" ::: "memory");
        }
#pragma unroll
        for (int rb = 0; rb < 2; ++rb)
#pragma unroll
            for (int i = 0; i < 4; ++i) YBF[(row0 + 16 * rb + i) * 512 + col] = f2bf(gelu_tanh(acc[rb][i] + dsk * bf2f(ue[rb][i])));
    }
}

#define XB_TMO      128
#define XB_XCNT(j)  (256  + 64 * (j))
#define XB_XSUB(j)  (1280 + 64 * (j))
#define XB_XGEN(j)  (2304 + 64 * (j))
#define XB_TOP      3328
#define XB_TOPGEN   3392
#define XCD_BAR_WORDS 3456
#define XB_SPIN_CAP (1u << 18)

__device__ __forceinline__ unsigned xb_ld(unsigned* p)              { return __hip_atomic_load(p, __ATOMIC_RELAXED, __HIP_MEMORY_SCOPE_AGENT); }
__device__ __forceinline__ unsigned xb_add(unsigned* p, unsigned v) { return __hip_atomic_fetch_add(p, v, __ATOMIC_RELAXED, __HIP_MEMORY_SCOPE_AGENT); }
__device__ __forceinline__ unsigned xb_xcc_id() { return (unsigned)__builtin_amdgcn_s_getreg((3 << 11) | 20) & 0xFu; }
#define XB_SPIN(cond, bar) do { unsigned _sp = 0; while (cond) { __builtin_amdgcn_s_sleep(1); \
    if ((++_sp & 255u) == 0u) { if (xb_ld(&(bar)[XB_TMO])) break; if (_sp > XB_SPIN_CAP) { atomicAdd(&(bar)[XB_TMO], 1u); break; } } } } while (0)

struct XcdBarrier {
    unsigned* bar; unsigned x;
    volatile LAS unsigned* st;
};

__device__ __forceinline__ XcdBarrier xcd_barrier_post(unsigned* bar, volatile LAS unsigned* st) {
    XcdBarrier b; b.bar = bar; b.x = xb_xcc_id(); b.st = st;
    if (threadIdx.x == 0) (void)xb_add(&bar[XB_XCNT(b.x)], 1u);
    return b;
}
__device__ __forceinline__ void xcd_barrier_complete(unsigned* bar, unsigned x, unsigned& nloc, unsigned& nx) {
    const unsigned G = gridDim.x * gridDim.y * gridDim.z;
    unsigned sum, cnt, mine, sp = 0u;
    for (;;) {
        sum = 0u; cnt = 0u; mine = 0u;
#pragma unroll
        for (unsigned j = 0; j < 16; ++j) { const unsigned c = xb_ld(&bar[XB_XCNT(j)]); sum += c; cnt += (c > 0u) ? 1u : 0u; mine = (j == x) ? c : mine; }
        if (sum == G) break;
        __builtin_amdgcn_s_sleep(1);
        if ((++sp & 255u) == 0u) { if (xb_ld(&bar[XB_TMO])) break; if (sp > XB_SPIN_CAP) { atomicAdd(&bar[XB_TMO], 1u); break; } }
    }
    nloc = mine > 0u ? mine : 1u; nx = cnt > 0u ? cnt : 1u;
}

__device__ __forceinline__ void xcd_barrier(const XcdBarrier& b) {
    asm volatile("s_waitcnt vmcnt(0)" ::: "memory");
    __syncthreads();
    if (threadIdx.x == 0) {
        unsigned* bar = b.bar;
        __builtin_amdgcn_s_waitcnt(0);
        unsigned nloc = b.st[0], nx = b.st[1];
        if (nloc == 0u) { xcd_barrier_complete(bar, b.x, nloc, nx); b.st[0] = nloc; b.st[1] = nx; }
        const unsigned old = xb_add(&bar[XB_XSUB(b.x)], 1u);
        const unsigned gen = old / nloc;
        if (old + 1u == (gen + 1u) * nloc) {
            __builtin_amdgcn_fence(__ATOMIC_RELEASE, "agent");
            asm volatile("s_waitcnt vmcnt(0)" ::: "memory");
            const unsigned og = xb_add(&bar[XB_TOP], 1u);
            const unsigned tg = og / nx;
            if (og + 1u == (tg + 1u) * nx) xb_add(&bar[XB_TOPGEN], 1u);
            else XB_SPIN(xb_ld(&bar[XB_TOPGEN]) == tg, bar);
            __builtin_amdgcn_fence(__ATOMIC_ACQUIRE, "agent");
            xb_add(&bar[XB_XGEN(b.x)], 1u);
            asm volatile("s_waitcnt vmcnt(0)" ::: "memory");
        } else {
            XB_SPIN(xb_ld(&bar[XB_XGEN(b.x)]) == gen, bar);
            __builtin_amdgcn_fence(__ATOMIC_ACQUIRE, "agent");
            asm volatile("s_waitcnt vmcnt(0)" ::: "memory");
        }
    }
    __syncthreads();
}

constexpr int NPHASE = 18;
#ifdef MK_ONLY
#define PH_ON(x) (((MK_ONLY) >> (x)) & 1)
#else
#define PH_ON(x) true
#endif
#ifndef MK_LAYER_UNROLL
#define MK_LAYER_UNROLL 1
#endif
__global__ void __launch_bounds__(512, 2) mk_fwd(Args a) {
    extern __shared__ __attribute__((aligned(16))) unsigned char lds_raw[];
    LAS unsigned char* lds = (LAS unsigned char*)lds_raw;
    cg::grid_group grid = cg::this_grid();
    volatile LAS unsigned* MISC = (volatile LAS unsigned*)(lds + LDS_MISC);
    if (threadIdx.x < 32) MISC[threadIdx.x] = 0u;
    __syncthreads();
    const XcdBarrier xbar = xcd_barrier_post((unsigned*)(a.ws + WS_BAR), MISC + 8);
    const int lo = a.ph_lo, hi = a.ph_hi;
    if (lo < 0) grid.sync();
#define PB() int tid = threadIdx.x; asm volatile("" : "+v"(tid)); const int lane = tid & 63, wave = __builtin_amdgcn_readfirstlane(tid >> 6); Args al = a; { size_t z_ = 0; asm volatile("" : "+s"(z_)); al.ws = a.ws + z_; } int G = gridDim.x, bx = blockIdx.x; asm volatile("" : "+s"(G), "+s"(bx)); (void)lane; (void)wave; (void)G; (void)bx
#define IN(k) (lo <= (k) && (k) < hi)
#define SEAM(k) do { if (IN(k) && IN((k) + 1)) xcd_barrier(xbar); } while (0)
    if (IN(0) && PH_ON(0)) { PB(); phase_p0(al, lds, tid, wave, lane); }
    SEAM(0);
    if (IN(1) && PH_ON(1)) { PB(); phase_hn0(al, wave, lane); }
    SEAM(1);
#pragma unroll MK_LAYER_UNROLL
    for (int layer = 0; layer < 2; ++layer) {
        const int pb = 2 + 8 * layer;
        if (IN(pb + 0) && PH_ON(2)) { PB();
            pg8::Gemm g{(const bf16_t*)(al.ws + WS_HN), ((bf16_t*)(al.ws + WS_W)) + W_IN, NROW, 4352, 1024}; pg8::StaticOrder S; S.init(NROW, 4352, G, bx);
            EpiIn E{al.ws, (const float2*)(al.ws + WS_TAB + T_ROPE)};
            pg8::gemm_phase<EpiIn, pg8::StaticOrder, true, true>(lds, g, S, E);
        }
        SEAM(pb + 0);
        if (IN(pb + 1) && PH_ON(3)) {
            { PB(); unsigned* fw = (unsigned*)(al.ws + WS_BAR) + 3712 + 64 * layer;
              const int nchain = G < 64 ? G : 64;
              if (bx < nchain) {
                for (int cw = bx * 8 + wave; cw < 512; cw += nchain * 8) s5_chain_wave(al, layer, cw, lane);
                asm volatile("s_waitcnt vmcnt(0)" ::: "memory"); __syncthreads();
                if (tid == 0) { __builtin_amdgcn_fence(__ATOMIC_RELEASE, "agent"); asm volatile("s_waitcnt vmcnt(0)" ::: "memory"); __hip_atomic_fetch_add(fw, 1u, __ATOMIC_RELAXED, __HIP_MEMORY_SCOPE_AGENT); }
              } }
            const int ntask = layer == 0 ? 1152 : 1024;
            for (;;) { PB();
                unsigned* qw = (unsigned*)(al.ws + WS_BAR) + 3584 + 64 * layer;
                volatile LAS unsigned* qs = (volatile LAS unsigned*)(lds + LDS_MISC) + 16;
                __syncthreads();
                if (tid == 0) qs[0] = __hip_atomic_fetch_add(qw, 1u, __ATOMIC_RELAXED, __HIP_MEMORY_SCOPE_AGENT);
                __syncthreads();
                const int t = (int)qs[0];
                if (t >= ntask) break;
                int tb, th, tq; bool isdiff;
                if (t < 512) { isdiff = true; tb = t >> 6; th = (t >> 4) & 3; tq = 2 + (t & 15); }
                else if (t < 1024) { const int u = t - 512; isdiff = false; tb = u >> 6; th = (u >> 5) & 1; tq = 4 + (u & 31); }
                else if (t < 1088) { const int u = t - 1024; isdiff = true; tb = u >> 3; th = (u >> 1) & 3; tq = u & 1; }
                else { const int u = t - 1088; isdiff = false; tb = u >> 3; th = (u >> 2) & 1; tq = u & 3; }
                if (isdiff) diff_task(al, layer, tb, th, tq, lds, tid, wave, lane); else swa_task(al, layer, tb, th, tq, lds, tid, wave, lane);
            }
            { PB(); unsigned* fw = (unsigned*)(al.ws + WS_BAR) + 3712 + 64 * layer; const int nchain = G < 64 ? G : 64;
              __syncthreads();
              if (tid == 0) { unsigned sp = 0; while (__hip_atomic_load(fw, __ATOMIC_RELAXED, __HIP_MEMORY_SCOPE_AGENT) < (unsigned)nchain) { __builtin_amdgcn_s_sleep(2); if (++sp > (1u << 22)) break; }
                              __builtin_amdgcn_fence(__ATOMIC_ACQUIRE, "agent"); asm volatile("s_waitcnt vmcnt(0)" ::: "memory"); }
              __syncthreads();
              s5_pass3_wave(al, layer, bx * 8 + wave, G * 8, lds, wave, lane); }
        }
        SEAM(pb + 3);
        if (IN(pb + 4) && PH_ON(6)) {
            { PB(); pg8::Gemm g{(const bf16_t*)(al.ws + WS_YBF), ((bf16_t*)(al.ws + WS_W)) + W_GLU, NROW, 512, 512}; FlexOrder S; S.init(512, G, (layer == 0 && G == 256) ? ((bx + 144) & 255) : bx, layer == 1 ? 1 : 0);
              EpiRow<4> E{(bf16_t*)(al.ws + WS_SBG), 512, (const bf16_t*)(al.ws + WS_YBF), al.in[I_BGLU] + layer * 512, nullptr, 0, false, false, al.ws};
              pg8::gemm_phase<EpiRow<4>, FlexOrder, true, true>(lds, g, S, E); }
            if (layer == 0) { PB();
                pg8::Gemm g{(const bf16_t*)(al.ws + WS_HN), ((bf16_t*)(al.ws + WS_W)) + W_IN + (size_t)4352 * 1024, NROW, 3072, 1024}; FlexOrder S; S.init(3072, G, bx, 3);
                EpiRow<1> E{(bf16_t*)(al.ws + WS_MCTX), 3072, nullptr, nullptr, nullptr, 0, true, false, al.ws};
                pg8::gemm_phase<EpiRow<1>, FlexOrder, true, true>(lds, g, S, E);
            }
            { PB(); unsigned* fw = (unsigned*)(al.ws + WS_BAR) + 3840 + 64 * layer;
              unsigned* pc = (unsigned*)(al.ws + WS_BAR) + 3968 + 16 * layer + xbar.x;
              asm volatile("s_waitcnt vmcnt(0)" ::: "memory"); __syncthreads();
              if (tid == 0) { const unsigned nloc = xbar.st[0]; const unsigned old = __hip_atomic_fetch_add(pc, 1u, __ATOMIC_RELAXED, __HIP_MEMORY_SCOPE_AGENT);
                  if (old + 1u == nloc) { __builtin_amdgcn_fence(__ATOMIC_RELEASE, "agent"); asm volatile("s_waitcnt vmcnt(0)" ::: "memory"); __hip_atomic_fetch_add(fw, nloc, __ATOMIC_RELAXED, __HIP_MEMORY_SCOPE_AGENT); } } }
            if (layer == 1) {
                { PB(); FlexOrder S2; S2.init(1024, G, bx, 6); bf16_t* Wb = (bf16_t*)(al.ws + WS_W);
                  pg8::Gemm g{(const bf16_t*)(al.ws + WS_HN), Wb + W_IN + (size_t)4352 * 1024, NROW, 1024, 1024, (const bf16_t*)(al.ws + WS_HN), Wb + W_IN + (size_t)(4352 + 2048) * 1024, nullptr, nullptr};
                  EpiRow<1> E{nullptr, 1024, nullptr, nullptr, nullptr, 0, false, false, al.ws, false, true};
                  pg8::gemm_phase<EpiRow<1>, FlexOrder, true, true>(lds, g, S2, E); }
                { PB(); FlexOrder S2; S2.init(1024, G, bx, 6); bf16_t* Wb = (bf16_t*)(al.ws + WS_W);
                  pg8::Gemm g2{(const bf16_t*)(al.ws + WS_AQ), Wb + W_OA, NROW, 1024, 512, (const bf16_t*)(al.ws + WS_CQ), Wb + W_OC, nullptr, nullptr};
                  EpiRow<3> E{(bf16_t*)(al.ws + WS_YBUF), 1024, nullptr, nullptr, nullptr, 0, false, false, al.ws, false, true};
                  pg8::gemm_phase<EpiRow<3>, FlexOrder, true, true>(lds, g2, S2, E); }
            }
#pragma unroll
            for (int bo = (layer == 1 ? 2 : 0); bo < 3; ++bo) {
                const int br = bo == 0 ? 0 : (bo == 1 ? 2 : 1);
                if (bo == 2) { PB();
                    unsigned* fw = (unsigned*)(al.ws + WS_BAR) + 3840 + 64 * layer;
                    __syncthreads();
                    if (tid == 0) { unsigned sp = 0; while (__hip_atomic_load(fw, __ATOMIC_RELAXED, __HIP_MEMORY_SCOPE_AGENT) < (unsigned)G) { __builtin_amdgcn_s_sleep(2); if (++sp > (1u << 22)) break; }
                                    __builtin_amdgcn_fence(__ATOMIC_ACQUIRE, "agent"); asm volatile("s_waitcnt vmcnt(0)" ::: "memory"); }
                    __syncthreads();
                }
                { PB(); FlexOrder SL; SL.init(1024, G, bx, 1);
                  pg8::Gemm g{(const bf16_t*)(al.ws + WS_HN), ((bf16_t*)(al.ws + WS_W)) + W_IN + (size_t)(4352 + 1024 * br) * 1024, NROW, 1024, 1024}; EpiRow<1> E{nullptr, 1024, nullptr, nullptr, nullptr, 0, false, false, al.ws};
                  pg8::gemm_phase<EpiRow<1>, FlexOrder, true, true>(lds, g, SL, E); }
                { PB(); FlexOrder SO; SO.init(1024, G, bx, 1);
                  bf16_t* YB = (bf16_t*)(al.ws + WS_YBUF); const bf16_t* MC = layer == 0 ? (const bf16_t*)(al.ws + WS_MCTX) : nullptr;
                  pg8::Gemm g2{(const bf16_t*)(al.ws + (br == 0 ? WS_AQ : (br == 1 ? WS_SBG : WS_CQ))), ((bf16_t*)(al.ws + WS_W)) + (br == 0 ? W_OA : (br == 1 ? W_OB : W_OC)), NROW, 1024, 512};
                  if (bo == 0) { EpiRow<2> E{YB, 1024, nullptr, nullptr, MC, 1024 * br, false, false, al.ws}; pg8::gemm_phase<EpiRow<2>, FlexOrder, true, true>(lds, g2, SO, E); }
                  else { EpiRow<3> E{YB, 1024, nullptr, nullptr, MC, 1024 * br, false, false, al.ws}; pg8::gemm_phase<EpiRow<3>, FlexOrder, true, true>(lds, g2, SO, E); } }
            }
            if (layer == 0) { PB();
                FlexOrder S5; S5.init(1024, G, bx, 5);
                bf16_t* Wb = (bf16_t*)(al.ws + WS_W);
                pg8::Gemm g2{(const bf16_t*)(al.ws + WS_SBG), Wb + W_OB, NROW, 1024, 512, (const bf16_t*)(al.ws + WS_AQ), Wb + W_OA, (const bf16_t*)(al.ws + WS_CQ), Wb + W_OC};
                EpiRow<3> E{(bf16_t*)(al.ws + WS_YBUF), 1024, nullptr, nullptr, (const bf16_t*)(al.ws + WS_MCTX), 0, false, false, al.ws, true};
                pg8::gemm_phase<EpiRow<3>, FlexOrder, true, true>(lds, g2, S5, E);
            }
        }
        SEAM(pb + 5);
        if (IN(pb + 6) && PH_ON(8)) { PB();
            pg8::Gemm g{(const bf16_t*)(al.ws + WS_YBUF), ((bf16_t*)(al.ws + WS_W)) + W_OUT, NROW, 1024, 1024}; FlexOrder S; S.init(1024, G, bx, layer == 0 ? 2 : 1);
            EpiRow<0> E{(bf16_t*)(al.ws + WS_YO), 1024, nullptr, nullptr, nullptr, 0, false, false, al.ws};
            pg8::gemm_phase<EpiRow<0>, FlexOrder, true, true>(lds, g, S, E);
            if (layer == 0) { const int nb = G > 32 ? G - 32 : 0; if (bx >= 32) weights_layer(al, 1, lds, (bx - 32) * 8 + wave, nb * 8, wave, lane, 0); }
        }
        SEAM(pb + 6);
        if (IN(pb + 7) && PH_ON(9)) { PB(); phase_resid(al, layer, lds, wave, lane); }
        if (layer == 0) SEAM(pb + 7);
    }
#undef IN
#undef SEAM
#undef PB
}

extern "C" void kernel_launch(void* const* d_in, const int* in_sizes, int n_in, void* d_out, int out_size, void* d_ws, size_t ws_size, hipStream_t stream) {
    static int grid = 0;
    if (grid == 0) {
        if (n_in != 29 || ws_size < WS_END) { fprintf(stderr, "kernel_launch: unexpected n_in %d / ws %zu\n", n_in, ws_size); grid = -1; return; }
        int dev = 0, cus = 0, per_cu = 0;
        hipGetDevice(&dev); hipDeviceGetAttribute(&cus, hipDeviceAttributeMultiprocessorCount, dev);
        hipFuncSetAttribute((const void*)mk_fwd, hipFuncAttributeMaxDynamicSharedMemorySize, LDS_BYTES);
        hipOccupancyMaxActiveBlocksPerMultiprocessor(&per_cu, (const void*)mk_fwd, 512, LDS_BYTES);
        if (per_cu < 1) { fprintf(stderr, "kernel_launch: occupancy query reports %d blocks per CU\n", per_cu); per_cu = 1; }
        (void)hipGetLastError();
        grid = cus;
        fprintf(stderr, "kernel_launch: grid %d (cus %d, per_cu %d)\n", grid, cus, per_cu);
    }
    if (grid < 0) return;
    (void)hipMemsetAsync((char*)d_ws + WS_BAR, 0, 16384, stream);
    Args a{};
    for (int i = 0; i < 29; ++i) a.in[i] = (const float*)d_in[i];
    a.out = (float*)d_out; a.ws = (unsigned char*)d_ws;
#if MK_PER_PHASE
    for (int ph = 0; ph < NPHASE; ++ph) { a.ph_lo = ph; a.ph_hi = ph + 1; hipLaunchKernelGGL(mk_fwd, dim3(grid), dim3(512), LDS_BYTES, stream, a); }
#else
    a.ph_lo = 0; a.ph_hi = NPHASE;
    void* args[] = {&a};
    hipError_t e = hipLaunchCooperativeKernel((const void*)mk_fwd, dim3(grid), dim3(512), args, LDS_BYTES, stream);
    if (e != hipSuccess) fprintf(stderr, "kernel_launch: cooperative launch failed: %s (grid %d)\n", hipGetErrorString(e), grid);
#endif
}
```
